# Optimizing an MI355X kernel written in HIP

```python
import math
import jax, jax.numpy as jnp
from jax import lax
import numpy as np

D_MODEL = 4096
BATCH = 2
SEQ = 8192
DEPTH = 2

CHUNK = 64
M_HEADS = 8
M_V_DIM = D_MODEL // (2 * M_HEADS)
M_QK_DIM = M_V_DIM // 2
M_WIDTH = M_HEADS * M_V_DIM
QK_WIDTH = M_HEADS * M_QK_DIM
CONV_WIDTH = 4
S5_WIDTH = D_MODEL // 4
S5_GROUP = 16
S5_GROUPS = S5_WIDTH // S5_GROUP
S5_STATE = 64
D_FF = 4 * D_MODEL
EPS = 1e-6
PROJ_WIDTH = 2 * QK_WIDTH + 2 * M_WIDTH + 2 * M_HEADS + S5_WIDTH + 2 * D_MODEL

kernel_name = 'hybrid_mlstm_s5_gated_block'


def rms_norm(x, gain):
    xf = x.astype(jnp.float32)
    y = xf * lax.rsqrt(jnp.mean(xf * xf, axis=-1, keepdims=True) + EPS)
    return (y * gain.astype(jnp.float32)).astype(x.dtype)


def causal_depthwise_conv(x, w):
    width = w.shape[0]
    ch = x.shape[-1]
    return lax.conv_general_dilated(
        x, w[:, None, :].astype(x.dtype), window_strides=(1,),
        padding=[(width - 1, 0)], dimension_numbers=('NWC', 'WIO', 'NWC'),
        feature_group_count=ch)


def mlstm_chunkwise(q, k, v, log_i, f_pre):
    bsz, nh, seq, dk = q.shape
    dv = v.shape[-1]
    nc = seq // CHUNK
    f32 = jnp.float32
    q = q.astype(f32).reshape(bsz, nh, nc, CHUNK, dk) * (dk ** -0.5)
    k = k.astype(f32).reshape(bsz, nh, nc, CHUNK, dk)
    v = v.astype(f32).reshape(bsz, nh, nc, CHUNK, dv)
    log_i = log_i.astype(f32).reshape(bsz, nh, nc, CHUNK)
    log_f = jax.nn.log_sigmoid(f_pre.astype(f32)).reshape(bsz, nh, nc, CHUNK)
    b = jnp.cumsum(log_f, axis=-1)
    g = b[..., -1]
    a = g[..., None] - b + log_i
    a_max = jnp.max(a, axis=-1)
    w_kv = jnp.exp(a - a_max[..., None])
    c_hat = jnp.einsum('bhcsd,bhcse->bhcde', w_kv[..., None] * k, v)
    n_hat = jnp.einsum('bhcs,bhcsd->bhcd', w_kv, k)

    def step(carry, xs):
        c_st, n_st, m_st = carry
        g_c, am_c, ch_c, nh_c = xs
        m_new = jnp.maximum(g_c + m_st, am_c)
        s_old = jnp.exp(g_c + m_st - m_new)
        s_new = jnp.exp(am_c - m_new)
        c_new = s_old[..., None, None] * c_st + s_new[..., None, None] * ch_c
        n_new = s_old[..., None] * n_st + s_new[..., None] * nh_c
        return (c_new, n_new, m_new), (c_st, n_st, m_st)

    init = (jnp.zeros((bsz, nh, dk, dv), f32), jnp.zeros((bsz, nh, dk), f32),
            jnp.zeros((bsz, nh), f32))
    xs = (jnp.moveaxis(g, -1, 0), jnp.moveaxis(a_max, -1, 0),
          jnp.moveaxis(c_hat, 2, 0), jnp.moveaxis(n_hat, 2, 0))
    _, (c_prev, n_prev, m_prev) = lax.scan(step, init, xs)
    c_prev = jnp.moveaxis(c_prev, 0, 2)
    n_prev = jnp.moveaxis(n_prev, 0, 2)
    m_prev = jnp.moveaxis(m_prev, 0, 2)

    causal = jnp.tril(jnp.ones((CHUNK, CHUNK), dtype=bool))
    d_mat = jnp.where(causal, b[..., :, None] - b[..., None, :] + log_i[..., None, :], -jnp.inf)
    m_inter = b + m_prev[..., None]
    m_t = jnp.maximum(m_inter, jnp.max(d_mat, axis=-1))
    p = jnp.exp(d_mat - m_t[..., None])
    s = jnp.einsum('bhctd,bhcsd->bhcts', q, k) * p
    scale_inter = jnp.exp(m_inter - m_t)
    num = (jnp.einsum('bhcts,bhcse->bhcte', s, v)
           + scale_inter[..., None] * jnp.einsum('bhctd,bhcde->bhcte', q, c_prev))
    den = jnp.sum(s, axis=-1) + scale_inter * jnp.einsum('bhctd,bhcd->bhct', q, n_prev)
    h = num / jnp.maximum(jnp.abs(den), jnp.exp(-m_t))[..., None]
    return h.reshape(bsz, nh, seq, dv)


def _complex_affine_combine(e1, e2):
    ar1, ai1, br1, bi1 = e1
    ar2, ai2, br2, bi2 = e2
    ar = ar2 * ar1 - ai2 * ai1
    ai = ar2 * ai1 + ai2 * ar1
    br = ar2 * br1 - ai2 * bi1 + br2
    bi = ar2 * bi1 + ai2 * br1 + bi2
    return (ar, ai, br, bi)


def s5_ssm(u, a_re, a_im, log_step, b_re, b_im, c_re, c_im, d_skip):
    bsz, seq, _ = u.shape
    f32 = jnp.float32
    u = u.astype(f32)
    lam_re = jnp.minimum(a_re.astype(f32), -1e-4)
    lam_im = a_im.astype(f32)
    dt = jnp.exp(log_step.astype(f32))[:, None]
    mag = jnp.exp(lam_re * dt)
    bar_re = mag * jnp.cos(lam_im * dt)
    bar_im = mag * jnp.sin(lam_im * dt)
    den = lam_re * lam_re + lam_im * lam_im
    nr = bar_re - 1.0
    r_re = (nr * lam_re + bar_im * lam_im) / den
    r_im = (bar_im * lam_re - nr * lam_im) / den
    b_re = b_re.astype(f32)
    b_im = b_im.astype(f32)
    bb_re = r_re[..., None] * b_re - r_im[..., None] * b_im
    bb_im = r_re[..., None] * b_im + r_im[..., None] * b_re
    ug = u.reshape(bsz, seq, S5_GROUPS, S5_GROUP)
    bu_re = jnp.einsum('bsgn,gpn->bsgp', ug, bb_re)
    bu_im = jnp.einsum('bsgn,gpn->bsgp', ug, bb_im)
    a_re_t = jnp.broadcast_to(bar_re, (1, seq, S5_GROUPS, S5_STATE))
    a_im_t = jnp.broadcast_to(bar_im, (1, seq, S5_GROUPS, S5_STATE))
    _, _, x_re, x_im = lax.associative_scan(
        _complex_affine_combine, (a_re_t, a_im_t, bu_re, bu_im), axis=1)
    y = (jnp.einsum('bsgp,gnp->bsgn', x_re, c_re.astype(f32))
         - jnp.einsum('bsgp,gnp->bsgn', x_im, c_im.astype(f32)))
    return y.reshape(bsz, seq, S5_WIDTH) + d_skip.astype(f32) * u


def hybrid_mixer(xn, w_in, conv_qk, b_igate, b_fgate, mh_norm_gain, p_a,
                 s5_a_re, s5_a_im, s5_log_step, s5_b_re, s5_b_im, s5_c_re, s5_c_im,
                 s5_d, w_glu, b_glu, p_b, w_out):
    bsz, seq, _ = xn.shape
    proj = xn @ w_in
    o1 = 2 * QK_WIDTH
    o2 = o1 + M_WIDTH
    o3 = o2 + M_WIDTH
    o4 = o3 + M_HEADS
    o5 = o4 + M_HEADS
    o6 = o5 + S5_WIDTH
    o7 = o6 + D_MODEL
    qk, v, o_pre, i_pre, f_pre, u, g_a, g_b = jnp.split(proj, [o1, o2, o3, o4, o5, o6, o7], axis=-1)

    qk = jax.nn.silu(causal_depthwise_conv(qk, conv_qk))
    q, k = jnp.split(qk, 2, axis=-1)

    def heads(t, d):
        return t.reshape(bsz, seq, M_HEADS, d).transpose(0, 2, 1, 3)

    h = mlstm_chunkwise(heads(q, M_QK_DIM), heads(k, M_QK_DIM), heads(v, M_V_DIM),
                        (i_pre + b_igate).transpose(0, 2, 1),
                        (f_pre + b_fgate).transpose(0, 2, 1))
    h = h.transpose(0, 2, 1, 3)
    mu = jnp.mean(h, axis=-1, keepdims=True)
    hc = h - mu
    var = jnp.mean(hc * hc, axis=-1, keepdims=True)
    h = hc * lax.rsqrt(var + EPS) * mh_norm_gain.astype(jnp.float32).reshape(M_HEADS, M_V_DIM)
    h = h.reshape(bsz, seq, M_WIDTH) * jax.nn.sigmoid(o_pre.astype(jnp.float32))
    y_a = h.astype(xn.dtype) @ p_a

    y_s = s5_ssm(u, s5_a_re, s5_a_im, s5_log_step, s5_b_re, s5_b_im, s5_c_re, s5_c_im, s5_d)
    z = jax.nn.gelu(y_s).astype(xn.dtype)
    z = z * jax.nn.sigmoid(z @ w_glu + b_glu)
    y_b = z @ p_b

    merged = jax.nn.sigmoid(g_a) * y_a + jax.nn.sigmoid(g_b) * y_b
    return merged @ w_out


def setup_inputs(seed: int = 0) -> dict:
    key = jax.random.key(seed)
    ks = jax.random.split(key, 26)
    f32 = jnp.float32

    def nrm(k, shape, scale):
        return jax.random.normal(k, shape, f32) * scale

    x = nrm(ks[0], (BATCH, SEQ, D_MODEL), 1.0)
    pre_mix_gain = 1.0 + nrm(ks[1], (DEPTH, D_MODEL), 0.05)
    post_mix_gain = 1.0 + nrm(ks[2], (DEPTH, D_MODEL), 0.05)
    pre_mlp_gain = 1.0 + nrm(ks[3], (DEPTH, D_MODEL), 0.05)
    post_mlp_gain = 1.0 + nrm(ks[4], (DEPTH, D_MODEL), 0.05)
    w_in = nrm(ks[5], (DEPTH, D_MODEL, PROJ_WIDTH), D_MODEL ** -0.5)
    conv_qk = nrm(ks[6], (DEPTH, CONV_WIDTH, 2 * QK_WIDTH), CONV_WIDTH ** -0.5)
    b_igate = nrm(ks[7], (DEPTH, M_HEADS), 0.1)
    b_fgate = jnp.linspace(3.0, 6.0, M_HEADS, dtype=f32)[None, :] + nrm(ks[8], (DEPTH, M_HEADS), 0.1)
    mh_norm_gain = 1.0 + nrm(ks[9], (DEPTH, M_WIDTH), 0.05)
    p_a = nrm(ks[10], (DEPTH, M_WIDTH, D_MODEL), M_WIDTH ** -0.5)
    s5_a_re = -0.5 + nrm(ks[11], (DEPTH, S5_GROUPS, S5_STATE), 0.01)
    s5_a_im = (math.pi * jnp.arange(S5_STATE, dtype=f32))[None, None, :] + nrm(ks[12], (DEPTH, S5_GROUPS, S5_STATE), 0.01)
    s5_log_step = jax.random.uniform(ks[13], (DEPTH, S5_GROUPS), f32, math.log(1e-3), math.log(1e-1))
    s5_b_re = nrm(ks[14], (DEPTH, S5_GROUPS, S5_STATE, S5_GROUP), (2 * S5_GROUP) ** -0.5)
    s5_b_im = nrm(ks[15], (DEPTH, S5_GROUPS, S5_STATE, S5_GROUP), (2 * S5_GROUP) ** -0.5)
    s5_c_re = nrm(ks[16], (DEPTH, S5_GROUPS, S5_GROUP, S5_STATE), S5_STATE ** -0.5)
    s5_c_im = nrm(ks[17], (DEPTH, S5_GROUPS, S5_GROUP, S5_STATE), S5_STATE ** -0.5)
    s5_d = nrm(ks[18], (DEPTH, S5_WIDTH), 1.0)
    w_glu = nrm(ks[19], (DEPTH, S5_WIDTH, S5_WIDTH), S5_WIDTH ** -0.5)
    b_glu = nrm(ks[20], (DEPTH, S5_WIDTH), 0.01)
    p_b = nrm(ks[21], (DEPTH, S5_WIDTH, D_MODEL), S5_WIDTH ** -0.5)
    w_out = nrm(ks[22], (DEPTH, D_MODEL, D_MODEL), D_MODEL ** -0.5)
    w_ff1 = nrm(ks[23], (DEPTH, D_MODEL, D_FF), D_MODEL ** -0.5)
    w_ff2 = nrm(ks[24], (DEPTH, D_FF, D_MODEL), D_FF ** -0.5)
    return {'x': x, 'pre_mix_gain': pre_mix_gain, 'post_mix_gain': post_mix_gain,
            'pre_mlp_gain': pre_mlp_gain, 'post_mlp_gain': post_mlp_gain,
            'w_in': w_in, 'conv_qk': conv_qk, 'b_igate': b_igate, 'b_fgate': b_fgate,
            'mh_norm_gain': mh_norm_gain, 'p_a': p_a,
            's5_a_re': s5_a_re, 's5_a_im': s5_a_im, 's5_log_step': s5_log_step,
            's5_b_re': s5_b_re, 's5_b_im': s5_b_im, 's5_c_re': s5_c_re, 's5_c_im': s5_c_im,
            's5_d': s5_d, 'w_glu': w_glu, 'b_glu': b_glu, 'p_b': p_b, 'w_out': w_out,
            'w_ff1': w_ff1, 'w_ff2': w_ff2}


def reference(x, pre_mix_gain, post_mix_gain, pre_mlp_gain, post_mlp_gain, w_in, conv_qk,
              b_igate, b_fgate, mh_norm_gain, p_a, s5_a_re, s5_a_im, s5_log_step,
              s5_b_re, s5_b_im, s5_c_re, s5_c_im, s5_d, w_glu, b_glu, p_b, w_out,
              w_ff1, w_ff2):
    for l in range(DEPTH):
        xn = rms_norm(x, pre_mix_gain[l])
        mix = hybrid_mixer(xn, w_in[l], conv_qk[l], b_igate[l], b_fgate[l], mh_norm_gain[l], p_a[l],
                           s5_a_re[l], s5_a_im[l], s5_log_step[l], s5_b_re[l], s5_b_im[l],
                           s5_c_re[l], s5_c_im[l], s5_d[l], w_glu[l], b_glu[l], p_b[l], w_out[l])
        x = x + rms_norm(mix, post_mix_gain[l])
        hn = rms_norm(x, pre_mlp_gain[l])
        ff = jnp.square(jax.nn.relu(hn @ w_ff1[l])) @ w_ff2[l]
        x = x + rms_norm(ff, post_mlp_gain[l])
    return x
```

```cpp
#include <hip/hip_runtime.h>
#include <cstdio>
#include <cstdint>

#ifndef MK_PH_MASK
#define MK_PH_MASK 0xfff
#endif
#ifndef MK_DUP_MASK
#define MK_DUP_MASK 0x000
#endif
#ifndef MK_DUP_ML1
#define MK_DUP_ML1 0
#endif
#ifndef MK_DUP_S51
#define MK_DUP_S51 0
#endif
#ifndef MK_DUP_ML2
#define MK_DUP_ML2 0
#endif
#ifndef MK_DUP_S52
#define MK_DUP_S52 0
#endif
#ifndef MK_FF2_AUXA
#define MK_FF2_AUXA 0
#endif
#ifndef MK_NT_STORE
#define MK_NT_STORE 0
#endif
#ifndef MK_DUP_EPI
#define MK_DUP_EPI 0
#endif
#ifndef MK_ONE_LAUNCH
#define MK_ONE_LAUNCH 1
#endif

namespace pg8 {
#define PG8_LAS __attribute__((address_space(3)))
typedef unsigned short bf16_t;
typedef short bf16x8 __attribute__((ext_vector_type(8)));
typedef float f32x4 __attribute__((ext_vector_type(4)));
typedef unsigned u32x4 __attribute__((ext_vector_type(4)));
typedef int v8i_t __attribute__((ext_vector_type(8)));
typedef short s16x16_t __attribute__((ext_vector_type(16)));
constexpr int BM = 256, BK = 64, HALF = 128, HTB = HALF * BK * 2  , STAGE_BYTES = 8 * HTB, NXCD = 8, WGM = 8;

__host__ __device__ __forceinline__ int lds_byte(int r, int c) { const int st = (r >> 4) * 2 + (c >> 5), rr = r & 15, cc = c & 31, ob = rr * 64 + cc * 2; return st * 1024 + (ob ^ (((ob >> 9) & 1) << 5)); }
__host__ __device__ __forceinline__ void stage_rc(int b, int& R, int& C) { const int st = b / 1024, sb = b % 1024, swz = sb ^ (((sb >> 9) & 1) << 5); R = (st >> 1) * 16 + swz / 64; C = (st & 1) * 32 + (swz % 64) / 2; }
__host__ __device__ __forceinline__ int perm32(int rho) { const int n = rho >> 4, i = rho & 15; return 8 * (i >> 2) + 4 * n + (i & 3); }

struct Unit { int pm, pn; };
struct Gemm { const bf16_t* A; const bf16_t* Bt; int M, N, K; int ksplit; };

struct StaticOrder {
    int nM, nN, nwg, G, c;
    __host__ __device__ void init(int M, int N, int G_, int c_) { nM = M / BM; nN = N / BM; nwg = nM * nN; G = G_; c = c_; }
    __host__ __device__ bool next(int i, Unit& u) const {
        const long L = (long)i * G + c; if (L >= nwg) return false;
        int wgid = (int)L; { const int q = nwg / NXCD, r = nwg % NXCD, xcd = wgid % NXCD, off = wgid / NXCD; wgid = (xcd < r ? xcd * (q + 1) : r * (q + 1) + (xcd - r) * q) + off; }
        const int nig = WGM * nN, gid = wgid / nig, fm = gid * WGM, gsz = (nM - fm) < WGM ? (nM - fm) : WGM;
        u.pm = fm + ((wgid % nig) % gsz); u.pn = (wgid % nig) / gsz; return true;
    }
    __device__ __forceinline__ void a_ready(const Unit&) const {}
    __device__ __forceinline__ void done(const Unit&) const {}
};

__device__ __forceinline__ unsigned cvt_pk_bf16(float lo, float hi) { unsigned r; asm volatile("s_nop 0\n\tv_cvt_pk_bf16_f32 %0, %1, %2" : "=v"(r) : "v"(lo), "v"(hi)); return r; }
__device__ __forceinline__ float sigm(float x) { return __builtin_amdgcn_rcpf(1.0f + __builtin_amdgcn_exp2f(-1.44269504f * x)); }
__device__ __forceinline__ f32x4 sigm4(f32x4 v) { return (f32x4){sigm(v[0]), sigm(v[1]), sigm(v[2]), sigm(v[3])}; }
__device__ __forceinline__ void unpack8(const u32x4 w, f32x4& a, f32x4& b) {
    a = (f32x4){__uint_as_float(w.x << 16), __uint_as_float(w.x & 0xffff0000u), __uint_as_float(w.y << 16), __uint_as_float(w.y & 0xffff0000u)};
    b = (f32x4){__uint_as_float(w.z << 16), __uint_as_float(w.z & 0xffff0000u), __uint_as_float(w.w << 16), __uint_as_float(w.w & 0xffff0000u)};
}

struct EpiF32 {
    static constexpr bool PERM = false, AFTER_DRAIN = false;
    float* C; int ldc;
    __device__ __forceinline__ void operator()(const f32x4 (&acc)[2][2][4][2], const Unit& u, int wr, int wc, int fr, int fq) const {
        const int row0 = u.pm * BM + wr * 64 + fr, col0 = u.pn * BM + wc * 32 + 4 * fq;
#pragma unroll
        for (int ai = 0; ai < 2; ++ai)
#pragma unroll
            for (int m = 0; m < 4; ++m) { float* rowp = C + (size_t)(row0 + ai * HALF + m * 16) * ldc + col0;
#pragma unroll
                for (int bj = 0; bj < 2; ++bj)
#pragma unroll
                    for (int n = 0; n < 2; ++n) *(f32x4*)(rowp + bj * HALF + n * 16) = acc[ai][bj][m][n]; }
    }
};
template <int MODE> struct EpiB {
    static constexpr bool PERM = true, AFTER_DRAIN = false;
    bf16_t* O; int ldc; const bf16_t* X1; const bf16_t* X2; const float* bias;
    bf16_t *pQK, *pV, *pSO, *pU, *pGA, *pGB;
    int ldx;
    __device__ __forceinline__ void operator()(const f32x4 (&acc)[2][2][4][2], const Unit& u, int wr, int wc, int fr, int fq) const {
        bf16_t* base = O; int ld = ldc; int colt = u.pn * BM; bool act = false, isU = false;
        if (MODE == 0) {
            const int pn = u.pn;
            if (pn < 8) { base = pQK; ld = 2048; colt = pn * BM; }
            else if (pn < 16) { base = pV; ld = 2048; colt = (pn - 8) * BM; }
            else if (pn < 24) { base = pSO; ld = 2048; colt = (pn - 16) * BM; act = true; }
            else if (pn < 28) { base = pU; ld = 1024; colt = (pn - 24) * BM; isU = true; }
            else if (pn < 44) { base = pGA; ld = 4096; colt = (pn - 28) * BM; act = true; }
            else { base = pGB; ld = 4096; colt = (pn - 44) * BM; act = true; }
        }
        const int row0 = u.pm * BM + wr * 64 + fr, col0 = colt + wc * 32 + 8 * fq;
        u32x4 lx[(MODE == 2) ? 2 : 1][4][2];
        if (MODE == 2) {
#pragma unroll
            for (int ai = 0; ai < 2; ++ai)
#pragma unroll
                for (int m = 0; m < 4; ++m)
#pragma unroll
                    for (int bj = 0; bj < 2; ++bj) lx[ai][m][bj] = *(const u32x4*)(X1 + (size_t)(row0 + ai * HALF + m * 16) * ldx + col0 + bj * HALF);
            asm volatile("" ::: "memory"); }
#pragma unroll
        for (int ai = 0; ai < 2; ++ai)
#pragma unroll
            for (int m = 0; m < 4; ++m) { const size_t ro = (size_t)(row0 + ai * HALF + m * 16) * ld + col0;
#pragma unroll
                for (int bj = 0; bj < 2; ++bj) { f32x4 v0 = acc[ai][bj][m][0], v1 = acc[ai][bj][m][1]; size_t o = ro + bj * HALF;
                    if (MODE == 0) { if (act) { v0 = sigm4(v0); v1 = sigm4(v1); }
                        if (isU) { const int row = row0 + ai * HALF + m * 16, col = col0 + bj * HALF; o = ((size_t)((row >> 13) * 64 + (col >> 4)) * 8192 + (row & 8191)) * 16 + (col & 8); } }
                    if (MODE == 1) { v0 = __builtin_elementwise_max(v0, (f32x4){0.f, 0.f, 0.f, 0.f}); v1 = __builtin_elementwise_max(v1, (f32x4){0.f, 0.f, 0.f, 0.f}); v0 = v0 * v0; v1 = v1 * v1; }
                    if (MODE == 2) { const float* bp = bias + col0 + bj * HALF; const f32x4 b0 = *(const f32x4*)bp, b1 = *(const f32x4*)(bp + 4);
                        f32x4 x0, x1; unpack8(lx[(MODE == 2) ? ai : 0][m][bj], x0, x1); v0 = x0 * sigm4(v0 + b0); v1 = x1 * sigm4(v1 + b1); }
                    if (MODE == 3) { f32x4 x0, x1; unpack8(*(const u32x4*)(X1 + o), x0, x1); v0 = x0 * v0; v1 = x1 * v1; }
                    if (MODE == 4) { f32x4 x0, x1, y0, y1; unpack8(*(const u32x4*)(X1 + o), x0, x1); unpack8(*(const u32x4*)(X2 + o), y0, y1); v0 = x0 + y0 * v0; v1 = x1 + y1 * v1; }
                    u32x4 w; w.x = cvt_pk_bf16(v0[0], v0[1]); w.y = cvt_pk_bf16(v0[2], v0[3]); w.z = cvt_pk_bf16(v1[0], v1[1]); w.w = cvt_pk_bf16(v1[2], v1[3]);
                    if (MK_NT_STORE && (MODE == 0 || MODE == 1)) __builtin_nontemporal_store(w, (u32x4*)(base + o)); else *(u32x4*)(base + o) = w; } }
    }
};

__device__ __forceinline__ unsigned gate_q4(f32x4 v, float scale) {
    unsigned q[4];
#pragma unroll
    for (int j = 0; j < 4; ++j) { const float t = __builtin_fmaf(255.0f, sigm(v[j] * scale), 0.5f); const unsigned u = (unsigned)t; q[j] = u < 1u ? 1u : u; }
    return q[0] | (q[1] << 8) | (q[2] << 16) | (q[3] << 24);
}
__device__ __forceinline__ f32x4 gate_u4(unsigned w) { return (f32x4){(float)(w & 0xffu), (float)((w >> 8) & 0xffu), (float)((w >> 16) & 0xffu), (float)(w >> 24)}; }
struct EpiGate8 {
    static constexpr bool PERM = true, AFTER_DRAIN = false;
    unsigned char* pGA; unsigned char* pGB; float scale;
    __device__ __forceinline__ void operator()(const f32x4 (&acc)[2][2][4][2], const Unit& u, int wr, int wc, int fr, int fq) const {
        unsigned char* base = (u.pn < 16) ? pGA : pGB; const int colt = (u.pn & 15) * BM;
        const int row0 = u.pm * BM + wr * 64 + fr, col0 = colt + wc * 64 + 16 * fq;
#pragma unroll
        for (int ai = 0; ai < 2; ++ai)
#pragma unroll
            for (int m = 0; m < 4; ++m) { u32x4 w;
                w.x = gate_q4(acc[ai][0][m][0], scale); w.y = gate_q4(acc[ai][0][m][1], scale); w.z = gate_q4(acc[ai][1][m][0], scale); w.w = gate_q4(acc[ai][1][m][1], scale);
                *(u32x4*)(base + (size_t)(row0 + ai * HALF + m * 16) * 4096 + col0) = w; }
    }
};

struct EpiMerge {
    static constexpr bool PERM = true, AFTER_DRAIN = false;
    bf16_t* O; const unsigned char* SGA; const unsigned char* SGB; int ldc;
    __device__ __forceinline__ void mid(f32x4 (&acc)[2][2][4][2], const Unit& u, int wr, int wc, int fr, int fq) const {
        const int row0 = u.pm * BM + wr * 64 + fr, col0 = u.pn * BM + wc * 64 + 16 * fq;
        u32x4 la[2][4], lb[2][4];
#pragma unroll
        for (int ai = 0; ai < 2; ++ai)
#pragma unroll
            for (int m = 0; m < 4; ++m) { const size_t o = (size_t)(row0 + ai * HALF + m * 16) * 4096 + col0; la[ai][m] = *(const u32x4*)(SGA + o); lb[ai][m] = *(const u32x4*)(SGB + o); }
        asm volatile("" ::: "memory");
#pragma unroll
        for (int ai = 0; ai < 2; ++ai)
#pragma unroll
            for (int m = 0; m < 4; ++m)
#pragma unroll
                for (int bj = 0; bj < 2; ++bj) { const f32x4 a0 = gate_u4(la[ai][m][2 * bj]), a1 = gate_u4(la[ai][m][2 * bj + 1]), b0 = gate_u4(lb[ai][m][2 * bj]), b1 = gate_u4(lb[ai][m][2 * bj + 1]);
#pragma unroll
                    for (int j = 0; j < 4; ++j) { acc[ai][bj][m][0][j] *= a0[j] * __builtin_amdgcn_rcpf(b0[j]); acc[ai][bj][m][1][j] *= a1[j] * __builtin_amdgcn_rcpf(b1[j]); } }
        asm volatile("" ::: "memory");
    }
    __device__ __forceinline__ void operator()(const f32x4 (&acc)[2][2][4][2], const Unit& u, int wr, int wc, int fr, int fq) const {
        const int row0 = u.pm * BM + wr * 64 + fr, col0 = u.pn * BM + wc * 32 + 8 * fq, colg = u.pn * BM + wc * 64 + 16 * fq;
        u32x4 lb[2][4];
#pragma unroll
        for (int ai = 0; ai < 2; ++ai)
#pragma unroll
            for (int m = 0; m < 4; ++m) lb[ai][m] = *(const u32x4*)(SGB + (size_t)(row0 + ai * HALF + m * 16) * 4096 + colg);
        asm volatile("" ::: "memory");
#pragma unroll
        for (int ai = 0; ai < 2; ++ai)
#pragma unroll
            for (int m = 0; m < 4; ++m)
#pragma unroll
                for (int bj = 0; bj < 2; ++bj) { const size_t o = (size_t)(row0 + ai * HALF + m * 16) * ldc + col0 + bj * HALF;
                    const f32x4 v0 = acc[ai][bj][m][0] * (gate_u4(lb[ai][m][2 * bj]) * (1.0f / 255.0f)), v1 = acc[ai][bj][m][1] * (gate_u4(lb[ai][m][2 * bj + 1]) * (1.0f / 255.0f));
                    u32x4 w; w.x = cvt_pk_bf16(v0[0], v0[1]); w.y = cvt_pk_bf16(v0[2], v0[3]); w.z = cvt_pk_bf16(v1[0], v1[1]); w.w = cvt_pk_bf16(v1[2], v1[3]);
                    *(u32x4*)(O + o) = w; }
    }
};

template <class Epi, class Sched, bool ALIGN_EPI = false, bool SP2 = false, int AUXA = 0, int AUXB = 0, bool SPLIT = false, bool FP8 = false>
__device__ __forceinline__ void gemm_phase(PG8_LAS unsigned char* lds, const Gemm g, const Sched& S, const Epi& E) {
    int tid_ = threadIdx.x; asm volatile("" : "+v"(tid_));
    const int tid = tid_, wid = __builtin_amdgcn_readfirstlane(tid >> 6), lane = tid & 63, wr = wid >> 2, wc = wid & 3, fr = lane & 15, fq = lane >> 4;
    const int K = g.K; int nt = K / BK;
    unsigned voffA[2], voffB[2];
#pragma unroll
    for (int i = 0; i < 2; ++i) { int R, C; stage_rc(tid * 16 + i * 8192, R, C); const int Rb = Epi::PERM ? ((R & ~31) + perm32(R & 31)) : R;
        voffA[i] = (unsigned)(R * K + C) * 2u; voffB[i] = (unsigned)(Rb * K + C) * 2u; }
    const size_t kstep = (size_t)(BK * 2);
    const size_t hstep = (size_t)HALF * K * 2;
    const size_t tstep = 2 * hstep;
    const unsigned ldsw = (unsigned)wid * 1024u;
    const int aoff = FP8 ? lds_byte(wr * 64 + fr, fq * 16) : lds_byte(wr * 64 + fr, fq * 8), boff = FP8 ? lds_byte(wc * 32 + fr, fq * 16) : lds_byte(wc * 32 + fr, fq * 8);
#define PG8_SA(b, h) (((b) * 2 + (h)) * HTB)
#define PG8_SB(b, h) ((4 + (b) * 2 + (h)) * HTB)
#define PG8_STAGE(bufoff, gbase, voff, aux) do { _Pragma("unroll") for (int _i = 0; _i < 2; ++_i) \
        __builtin_amdgcn_global_load_lds((const unsigned*)((const char*)(gbase) + (voff)[_i]), (PG8_LAS unsigned*)(lds + (bufoff) + ldsw + _i * 8192), 16, 0, aux); } while (0)
#define PG8_LDA(dst, b, h) do { if constexpr (FP8) { _Pragma("unroll") for (int m = 0; m < 4; ++m) { const bf16x8 _p0 = *(const PG8_LAS bf16x8*)(lds + PG8_SA(b, h) + aoff + m * 2048), _p1 = *(const PG8_LAS bf16x8*)(lds + PG8_SA(b, h) + aoff + m * 2048 + 16); dst##8[m] = __builtin_bit_cast(v8i_t, __builtin_shufflevector(_p0, _p1, 0, 1, 2, 3, 4, 5, 6, 7, 8, 9, 10, 11, 12, 13, 14, 15)); } } else _Pragma("unroll") for (int m = 0; m < 4; ++m) _Pragma("unroll") for (int k = 0; k < 2; ++k) dst[m][k] = *(const PG8_LAS bf16x8*)(lds + PG8_SA(b, h) + aoff + m * 2048 + k * 1024); } while (0)
#define PG8_LDB(dst, b, h) do { if constexpr (FP8) { _Pragma("unroll") for (int n = 0; n < 2; ++n) { const bf16x8 _p0 = *(const PG8_LAS bf16x8*)(lds + PG8_SB(b, h) + boff + n * 2048), _p1 = *(const PG8_LAS bf16x8*)(lds + PG8_SB(b, h) + boff + n * 2048 + 16); dst##8[n] = __builtin_bit_cast(v8i_t, __builtin_shufflevector(_p0, _p1, 0, 1, 2, 3, 4, 5, 6, 7, 8, 9, 10, 11, 12, 13, 14, 15)); } } else _Pragma("unroll") for (int n = 0; n < 2; ++n) _Pragma("unroll") for (int k = 0; k < 2; ++k) dst[n][k] = *(const PG8_LAS bf16x8*)(lds + PG8_SB(b, h) + boff + n * 2048 + k * 1024); } while (0)
#define PG8_MMA(ai, bj, At, Bt) do { __builtin_amdgcn_s_setprio(1); if constexpr (FP8) { _Pragma("unroll") for (int m = 0; m < 4; ++m) _Pragma("unroll") for (int n = 0; n < 2; ++n) { asm volatile("v_mfma_f32_16x16x128_f8f6f4 %0, %1, %2, %0" : "+v"(acc[ai][bj][m][n]) : "v"(Bt##8[n]), "v"(At##8[m])); } } else _Pragma("unroll") for (int m = 0; m < 4; ++m) _Pragma("unroll") for (int n = 0; n < 2; ++n) _Pragma("unroll") for (int k = 0; k < 2; ++k) \
        acc[ai][bj][m][n] = __builtin_amdgcn_mfma_f32_16x16x32_bf16(Bt[n][k], At[m][k], acc[ai][bj][m][n], 0, 0, 0); __builtin_amdgcn_s_setprio(0); } while (0)
#define PG8_WAIT_V(n) asm volatile("s_waitcnt vmcnt(" #n ")" ::: "memory")
#define PG8_WAIT_L(n) asm volatile("s_waitcnt lgkmcnt(" #n ")" ::: "memory")
#define PG8_BAR __builtin_amdgcn_s_barrier()
#define PG8_SCHED __builtin_amdgcn_sched_barrier(0)
    Unit cur, nxt; int ui = 0;
    if (!S.next(0, cur)) return;
    if constexpr (SPLIT) nt = g.ksplit;
    f32x4 acc[2][2][4][2];
#pragma unroll
    for (int a = 0; a < 2; ++a)
#pragma unroll
        for (int b = 0; b < 2; ++b)
#pragma unroll
            for (int m = 0; m < 4; ++m)
#pragma unroll
                for (int n = 0; n < 2; ++n) acc[a][b][m][n] = (f32x4){0.f, 0.f, 0.f, 0.f};
    bf16x8 At[4][2], B0[2][2], B1[2][2];
    v8i_t At8[4], B08[2], B18[2];
    int sc1 = 0x7f7f7f7f; asm volatile("" : "+v"(sc1));
    const char* cA = (const char*)g.A + (size_t)cur.pm * tstep; const char* cB = (const char*)g.Bt + (size_t)cur.pn * tstep;
    S.a_ready(cur);
    if constexpr (SP2) {
        PG8_STAGE(PG8_SB(0, 0), cB, voffB, AUXB); PG8_STAGE(PG8_SB(0, 1), cB + hstep, voffB, AUXB); PG8_STAGE(PG8_SA(0, 0), cA, voffA, AUXA); PG8_STAGE(PG8_SA(0, 1), cA + hstep, voffA, AUXA);
        if (wr == 1) PG8_BAR;
        PG8_WAIT_V(2); PG8_BAR;
        PG8_STAGE(PG8_SB(1, 0), cB + kstep, voffB, AUXB); PG8_STAGE(PG8_SA(1, 0), cA + kstep, voffA, AUXA); PG8_STAGE(PG8_SB(1, 1), cB + hstep + kstep, voffB, AUXB);
        PG8_WAIT_V(6); PG8_BAR;
    } else {
        PG8_STAGE(PG8_SB(0, 0), cB, voffB, AUXB); PG8_STAGE(PG8_SA(0, 0), cA, voffA, AUXA); PG8_STAGE(PG8_SB(0, 1), cB + hstep, voffB, AUXB); PG8_STAGE(PG8_SA(0, 1), cA + hstep, voffA, AUXA);
        if (wr == 1) PG8_BAR;
        PG8_WAIT_V(4); PG8_BAR;
        PG8_STAGE(PG8_SB(1, 0), cB + kstep, voffB, AUXB); PG8_STAGE(PG8_SA(1, 0), cA + kstep, voffA, AUXA); PG8_STAGE(PG8_SB(1, 1), cB + hstep + kstep, voffB, AUXB);
        PG8_WAIT_V(6); PG8_BAR;
    }
    for (;;) {
        const bool has_next = SPLIT ? S.next((ui + 1) >> 1, nxt) : S.next(ui + 1, nxt);
        const size_t nko = (SPLIT && ((ui + 1) & 1)) ? (size_t)g.ksplit * kstep : 0;
        const char* nA = has_next ? (const char*)g.A + (size_t)nxt.pm * tstep + nko : cA; const char* nB = has_next ? (const char*)g.Bt + (size_t)nxt.pn * tstep + nko : cB;
        for (int t = 0; t < nt; t += 2) {
            const bool last = (t == nt - 2);
            const char* a1 = cA + (size_t)(t + 1) * kstep;
            const char* a2 = last ? nA : cA + (size_t)(t + 2) * kstep; const char* b2 = last ? nB : cB + (size_t)(t + 2) * kstep;
            const char* a3 = a2 + kstep; const char* b3 = b2 + kstep;
            if (last && has_next) S.a_ready(nxt);
            if constexpr (SP2) {
            PG8_LDB(B0, 0, 0); PG8_LDB(B1, 0, 1); PG8_SCHED; PG8_LDA(At, 0, 0); PG8_STAGE(PG8_SA(1, 1), a1 + hstep, voffA, AUXA);
            PG8_WAIT_V(8); PG8_WAIT_L(0); PG8_BAR; PG8_MMA(0, 0, At, B0); PG8_MMA(0, 1, At, B1); PG8_BAR; PG8_SCHED;
            PG8_LDA(At, 0, 1); PG8_STAGE(PG8_SB(0, 0), b2, voffB, AUXB); PG8_STAGE(PG8_SB(0, 1), b2 + hstep, voffB, AUXB); PG8_STAGE(PG8_SA(0, 0), a2, voffA, AUXA);
            PG8_WAIT_V(8); PG8_WAIT_L(0); PG8_BAR; PG8_MMA(1, 0, At, B0); PG8_MMA(1, 1, At, B1); PG8_BAR; PG8_SCHED;
            PG8_LDB(B0, 1, 0); PG8_LDB(B1, 1, 1); PG8_SCHED; PG8_LDA(At, 1, 0); PG8_STAGE(PG8_SA(0, 1), a2 + hstep, voffA, AUXA);
            PG8_WAIT_V(8); PG8_WAIT_L(0); PG8_BAR; PG8_MMA(0, 0, At, B0); PG8_MMA(0, 1, At, B1); PG8_BAR; PG8_SCHED;
            PG8_LDA(At, 1, 1); PG8_STAGE(PG8_SB(1, 0), b3, voffB, AUXB); PG8_STAGE(PG8_SB(1, 1), b3 + hstep, voffB, AUXB); PG8_STAGE(PG8_SA(1, 0), a3, voffA, AUXA);
            PG8_WAIT_V(8); PG8_WAIT_L(0); PG8_BAR; PG8_MMA(1, 0, At, B0); PG8_MMA(1, 1, At, B1); PG8_BAR; PG8_SCHED;
            } else {
            PG8_LDB(B0, 0, 0); PG8_SCHED; PG8_LDA(At, 0, 0); PG8_STAGE(PG8_SA(1, 1), a1 + hstep, voffA, AUXA);
            PG8_WAIT_L(8); PG8_BAR; PG8_WAIT_L(0); PG8_MMA(0, 0, At, B0); PG8_BAR; PG8_SCHED;
            PG8_LDB(B1, 0, 1); PG8_STAGE(PG8_SB(0, 0), b2, voffB, AUXB);
            PG8_BAR; PG8_WAIT_L(0); PG8_MMA(0, 1, At, B1); PG8_BAR;
            PG8_LDA(At, 0, 1); PG8_STAGE(PG8_SA(0, 0), a2, voffA, AUXA);
            PG8_BAR; PG8_WAIT_L(0); PG8_MMA(1, 0, At, B0); PG8_BAR; PG8_SCHED;
            PG8_STAGE(PG8_SB(0, 1), b2 + hstep, voffB, AUXB);
            PG8_WAIT_V(6); PG8_BAR; PG8_MMA(1, 1, At, B1); PG8_BAR;
            PG8_LDB(B0, 1, 0); PG8_SCHED; PG8_LDA(At, 1, 0); PG8_STAGE(PG8_SA(0, 1), a2 + hstep, voffA, AUXA);
            PG8_WAIT_L(8); PG8_BAR; PG8_WAIT_L(0); PG8_MMA(0, 0, At, B0); PG8_BAR; PG8_SCHED;
            PG8_LDB(B1, 1, 1); PG8_STAGE(PG8_SB(1, 0), b3, voffB, AUXB);
            PG8_BAR; PG8_WAIT_L(0); PG8_MMA(0, 1, At, B1); PG8_BAR;
            PG8_LDA(At, 1, 1); PG8_STAGE(PG8_SA(1, 0), a3, voffA, AUXA);
            PG8_BAR; PG8_WAIT_L(0); PG8_MMA(1, 0, At, B0); PG8_BAR; PG8_SCHED;
            PG8_STAGE(PG8_SB(1, 1), b3 + hstep, voffB, AUXB);
            PG8_WAIT_V(6); PG8_BAR; PG8_MMA(1, 1, At, B1); PG8_BAR;
            }
        }
        if constexpr (FP8) asm volatile("s_nop 15\n\ts_nop 15" ::: "memory");
        if constexpr (ALIGN_EPI) { if (wr == 0) PG8_BAR; }
        if constexpr (SPLIT) { if ((ui & 1) == 0) E.mid(acc, cur, wr, wc, fr, fq); else E(acc, cur, wr, wc, fr, fq); }
        else if constexpr (!Epi::AFTER_DRAIN) { E(acc, cur, wr, wc, fr, fq); if (MK_DUP_EPI) { asm volatile("" ::: "memory"); E(acc, cur, wr, wc, fr, fq); } S.done(cur); }
        if (!has_next) break;
        if (!SPLIT || (ui & 1)) {
#pragma unroll
        for (int a = 0; a < 2; ++a)
#pragma unroll
            for (int b = 0; b < 2; ++b)
#pragma unroll
                for (int m = 0; m < 4; ++m)
#pragma unroll
                    for (int n = 0; n < 2; ++n) acc[a][b][m][n] = (f32x4){0.f, 0.f, 0.f, 0.f};
        }
        cur = nxt; cA = nA; cB = nB; ++ui;
        if constexpr (SPLIT) nt = (ui & 1) ? (K / BK - g.ksplit) : g.ksplit;
        if constexpr (ALIGN_EPI) { if (wr == 1) PG8_BAR; }
    }
    PG8_WAIT_V(0);
    if constexpr (!ALIGN_EPI) { if (wr == 0) PG8_BAR; }
    PG8_BAR;
    if constexpr (Epi::AFTER_DRAIN) { E.fused(acc, cur, wr, wc, fr, fq, lds, wid, lane); S.done(cur); }
#undef PG8_SA
#undef PG8_SB
#undef PG8_STAGE
#undef PG8_LDA
#undef PG8_LDB
#undef PG8_MMA
#undef PG8_WAIT_V
#undef PG8_WAIT_L
#undef PG8_BAR
#undef PG8_SCHED
}
}

constexpr int NWAVES = 8;
constexpr int BATCH = 2, SEQ = 8192, D = 4096, DEPTH = 2;
constexpr int M = BATCH * SEQ;
constexpr int HEADS = 8, DK = 128, DV = 256, MW = 2048, QKW = 1024;
constexpr int S5W = 1024, S5G = 64, S5N = 16, S5P = 64;
constexpr int DFF = 16384;
constexpr int HZW = 3072;
constexpr int PW = 15376, NP = 15360;
constexpr float EPS = 1e-6f;
constexpr int NPH = 12;

constexpr size_t MiB = 1u << 20;
constexpr size_t WS_CTL = 0, CTL_ZERO_BYTES = 1 * MiB;
constexpr size_t WS_GATES = 1 * MiB;
constexpr size_t WS_RS = 2 * MiB;
constexpr size_t WS_WIN = 4 * MiB, WS_WPA = 125 * MiB  , WS_WGLU = 149 * MiB, WS_WOUT = 151 * MiB, WS_WFF1 = 183 * MiB, WS_WFF2 = 311 * MiB;
constexpr size_t WS_W8 = WS_WIN + 56 * MiB;
constexpr float A8_SCALE = 16.0f, W8_SCALE = 256.0f;
constexpr size_t WS_A8 = 1520 * MiB, WS_END3 = 1584 * MiB;
constexpr size_t WS_XN = 439 * MiB;
constexpr size_t WS_BIG = 567 * MiB;
constexpr size_t WS_SGA = WS_BIG, WS_SGB = WS_BIG + 128 * MiB, WS_QK = WS_BIG + 256 * MiB, WS_V = WS_BIG + 320 * MiB, WS_SO = WS_BIG + 384 * MiB, WS_U = WS_BIG + 448 * MiB;
constexpr size_t WS_SG8A = WS_BIG + 128 * MiB, WS_SG8B = WS_BIG + 192 * MiB;
constexpr size_t WS_H1 = WS_BIG;
constexpr size_t WS_Y32 = 1079 * MiB;
constexpr size_t WS_HG = 1335 * MiB  , WS_Z = 1431 * MiB, WS_ST = 1463 * MiB, WS_END = 1503 * MiB;
constexpr int CW_BAR = 4096;

constexpr int RING_BYTES = 131072;
constexpr int LDSCTL_OFF = 155648, MISC_OFF = LDSCTL_OFF + 320;
constexpr int LDS_BYTES = 163840;

#define LAS __attribute__((address_space(3)))
typedef unsigned short bf16;
typedef unsigned v4u __attribute__((ext_vector_type(4)));
typedef unsigned v2u __attribute__((ext_vector_type(2)));
typedef float f32x4 __attribute__((ext_vector_type(4)));
typedef short bf16x8 __attribute__((ext_vector_type(8)));
#define LDS_WAIT() asm volatile("s_waitcnt lgkmcnt(0)" ::: "memory")
__device__ __forceinline__ float bf2f(unsigned short b) { return __uint_as_float(((unsigned)b) << 16); }
__device__ __forceinline__ unsigned pk2(float lo, float hi) { return pg8::cvt_pk_bf16(lo, hi); }
__device__ __forceinline__ float sigm(float x) { return __builtin_amdgcn_rcpf(1.0f + __builtin_amdgcn_exp2f(-1.44269504f * x)); }
__device__ __forceinline__ float wave_sum(float v) {
#pragma unroll
    for (int o = 1; o < 64; o <<= 1) v += __shfl_xor(v, o);
    return v;
}

#define XB_TMO      128
#define XB_XCNT(j)  (256  + 64 * (j))
#define XB_XSUB(j)  (1280 + 64 * (j))
#define XB_XGEN(j)  (2304 + 64 * (j))
#define XB_TOP      3328
#define XB_TOPGEN   3392
#define XCD_BAR_WORDS 3456
#define XB_SPIN_CAP (1u << 18)

__device__ __forceinline__ unsigned xb_ld(unsigned* p)              { return __hip_atomic_load(p, __ATOMIC_RELAXED, __HIP_MEMORY_SCOPE_AGENT); }
__device__ __forceinline__ unsigned xb_add(unsigned* p, unsigned v) { return __hip_atomic_fetch_add(p, v, __ATOMIC_RELAXED, __HIP_MEMORY_SCOPE_AGENT); }
__device__ __forceinline__ unsigned xb_xcc_id() { return (unsigned)__builtin_amdgcn_s_getreg((3 << 11) | 20) & 0xFu; }
#define XB_SPIN(cond, bar) do { unsigned _sp = 0; while (cond) { __builtin_amdgcn_s_sleep(1); \
    if ((++_sp & 255u) == 0u) { if (xb_ld(&(bar)[XB_TMO])) break; if (_sp > XB_SPIN_CAP) { atomicAdd(&(bar)[XB_TMO], 1u); break; } } } } while (0)

struct XcdBarrier {
    unsigned* bar; unsigned x;
    volatile LAS unsigned* st;
};

__device__ __forceinline__ XcdBarrier xcd_barrier_post(unsigned* bar, volatile LAS unsigned* st) {
    XcdBarrier b; b.bar = bar; b.x = xb_xcc_id(); b.st = st;
    if (threadIdx.x == 0) (void)xb_add(&bar[XB_XCNT(b.x)], 1u);
    return b;
}
__device__ __forceinline__ void xcd_barrier_complete(unsigned* bar, unsigned x, unsigned& nloc, unsigned& nx) {
    const unsigned G = gridDim.x * gridDim.y * gridDim.z;
    unsigned sum, cnt, mine, sp = 0u;
    for (;;) {
        sum = 0u; cnt = 0u; mine = 0u;
#pragma unroll
        for (unsigned j = 0; j < 16; ++j) { const unsigned c = xb_ld(&bar[XB_XCNT(j)]); sum += c; cnt += (c > 0u) ? 1u : 0u; mine = (j == x) ? c : mine; }
        if (sum == G) break;
        __builtin_amdgcn_s_sleep(1);
        if ((++sp & 255u) == 0u) { if (xb_ld(&bar[XB_TMO])) break; if (sp > XB_SPIN_CAP) { atomicAdd(&bar[XB_TMO], 1u); break; } }
    }
    nloc = mine > 0u ? mine : 1u; nx = cnt > 0u ? cnt : 1u;
}

__device__ __forceinline__ void xcd_barrier(const XcdBarrier& b) {
    asm volatile("s_waitcnt vmcnt(0)" ::: "memory");
    __syncthreads();
    if (threadIdx.x == 0) {
        unsigned* bar = b.bar;
        __builtin_amdgcn_s_waitcnt(0);
        unsigned nloc = b.st[0], nx = b.st[1];
        if (nloc == 0u) { xcd_barrier_complete(bar, b.x, nloc, nx); b.st[0] = nloc; b.st[1] = nx; }
        const unsigned old = xb_add(&bar[XB_XSUB(b.x)], 1u);
        const unsigned gen = old / nloc;
        if (old + 1u == (gen + 1u) * nloc) {
            __builtin_amdgcn_fence(__ATOMIC_RELEASE, "agent");
            asm volatile("s_waitcnt vmcnt(0)" ::: "memory");
            const unsigned og = xb_add(&bar[XB_TOP], 1u);
            const unsigned tg = og / nx;
            if (og + 1u == (tg + 1u) * nx) xb_add(&bar[XB_TOPGEN], 1u);
            else XB_SPIN(xb_ld(&bar[XB_TOPGEN]) == tg, bar);
            __builtin_amdgcn_fence(__ATOMIC_ACQUIRE, "agent");
            xb_add(&bar[XB_XGEN(b.x)], 1u);
            asm volatile("s_waitcnt vmcnt(0)" ::: "memory");
        } else {
            XB_SPIN(xb_ld(&bar[XB_XGEN(b.x)]) == gen, bar);
            __builtin_amdgcn_fence(__ATOMIC_ACQUIRE, "agent");
            asm volatile("s_waitcnt vmcnt(0)" ::: "memory");
        }
    }
    __syncthreads();
}

struct Params { const float* in[25]; float* out; unsigned char* ws; int l_lo, l_hi, ph_lo, ph_hi, li, pad; };

__device__ __forceinline__ void transpose_item(const float* W, int K, int N, int nsrc0, bf16* WT, int rdst0, LAS float* scr, int kb, int nb, int lane, const float* gk = nullptr, int pitch = 0, int koff = 0) {
    if (!pitch) pitch = K;
    const int k0 = 64 * kb, n0 = 32 * nb;
    { const int r8 = lane >> 3, c4 = (lane & 7) * 4; f32x4 v[8];
#pragma unroll
      for (int i = 0; i < 8; ++i) v[i] = *(const f32x4*)(W + (size_t)(k0 + 8 * i + r8) * N + nsrc0 + n0 + c4);
#pragma unroll
      for (int i = 0; i < 8; ++i) { LAS float* d = scr + (8 * i + r8) * 33 + c4; d[0] = v[i].x; d[1] = v[i].y; d[2] = v[i].z; d[3] = v[i].w; } }
    LDS_WAIT(); asm volatile("" ::: "memory");
    const int c = lane & 7;
    f32x4 ga = (f32x4){1.f, 1.f, 1.f, 1.f}, gb = ga; if (gk) { ga = *(const f32x4*)(gk + k0 + 8 * c); gb = *(const f32x4*)(gk + k0 + 8 * c + 4); }
#pragma unroll
    for (int j = 0; j < 4; ++j) { const int n = (lane >> 3) + 8 * j; const LAS float* s = scr + (8 * c) * 33 + n;
        v4u o; o.x = pk2(s[0 * 33] * ga.x, s[1 * 33] * ga.y); o.y = pk2(s[2 * 33] * ga.z, s[3 * 33] * ga.w); o.z = pk2(s[4 * 33] * gb.x, s[5 * 33] * gb.y); o.w = pk2(s[6 * 33] * gb.z, s[7 * 33] * gb.w);
        *(v4u*)(WT + (size_t)(rdst0 + n0 + n) * pitch + koff + k0 + 8 * c) = o; }
    LDS_WAIT(); asm volatile("" ::: "memory");
}

__device__ __forceinline__ unsigned pk4_fp8(float a, float b, float c, float d) { unsigned w = __builtin_amdgcn_cvt_pk_fp8_f32(a, b, 0u, false); return __builtin_amdgcn_cvt_pk_fp8_f32(c, d, w, true); }
__device__ __forceinline__ void transpose_item8(const float* W, int K, int N, int nsrc0, unsigned char* W8, int rdst0, LAS float* scr, int kb, int nb, int lane, const float* gk, float scale) {
    const int k0 = 64 * kb, n0 = 32 * nb;
    { const int r8 = lane >> 3, c4 = (lane & 7) * 4; f32x4 v[8];
#pragma unroll
      for (int i = 0; i < 8; ++i) v[i] = *(const f32x4*)(W + (size_t)(k0 + 8 * i + r8) * N + nsrc0 + n0 + c4);
#pragma unroll
      for (int i = 0; i < 8; ++i) { LAS float* d = scr + (8 * i + r8) * 33 + c4; d[0] = v[i].x; d[1] = v[i].y; d[2] = v[i].z; d[3] = v[i].w; } }
    LDS_WAIT(); asm volatile("" ::: "memory");
    const int c = lane & 7;
    const f32x4 ga = *(const f32x4*)(gk + k0 + 8 * c) * scale, gb = *(const f32x4*)(gk + k0 + 8 * c + 4) * scale;
#pragma unroll
    for (int j = 0; j < 4; ++j) { const int n = (lane >> 3) + 8 * j; const LAS float* s = scr + (8 * c) * 33 + n;
        v2u o; o.x = pk4_fp8(s[0 * 33] * ga.x, s[1 * 33] * ga.y, s[2 * 33] * ga.z, s[3 * 33] * ga.w); o.y = pk4_fp8(s[4 * 33] * gb.x, s[5 * 33] * gb.y, s[6 * 33] * gb.z, s[7 * 33] * gb.w);
        *(v2u*)(W8 + (size_t)(rdst0 + n0 + n) * K + k0 + 8 * c) = o; }
    LDS_WAIT(); asm volatile("" ::: "memory");
}

__device__ __forceinline__ void unpack8f(const v4u w, f32x4& a, f32x4& b) {
    a = (f32x4){__uint_as_float(w.x << 16), __uint_as_float(w.x & 0xffff0000u), __uint_as_float(w.y << 16), __uint_as_float(w.y & 0xffff0000u)};
    b = (f32x4){__uint_as_float(w.z << 16), __uint_as_float(w.z & 0xffff0000u), __uint_as_float(w.w << 16), __uint_as_float(w.w & 0xffff0000u)};
}
__device__ __forceinline__ void resid_rows(const float* xf, bf16* XB, const bf16* y, const float* gpost, bool xb_out, float* out32, float* RN, int gw, int ngw, int lane, bf16* XBo = nullptr, float* RNo = nullptr, unsigned char* A8 = nullptr) {
    if (!XBo) XBo = XB; if (!RNo) RNo = RN;
    for (int m = gw; m < M; m += ngw) {
        f32x4 xv[16];
        if (xf) { const f32x4* xr = (const f32x4*)(xf + (size_t)m * D) + 2 * lane;
#pragma unroll
            for (int j = 0; j < 8; ++j) { xv[2 * j] = xr[128 * j]; xv[2 * j + 1] = xr[128 * j + 1]; } }
        else { const v4u* xr = (const v4u*)(XB + (size_t)m * D) + lane; const float rn = RN[m];
#pragma unroll
            for (int j = 0; j < 8; ++j) { unpack8f(xr[64 * j], xv[2 * j], xv[2 * j + 1]); xv[2 * j] = xv[2 * j] * rn; xv[2 * j + 1] = xv[2 * j + 1] * rn; } }
        if (y) {
            f32x4 yv[16]; float ss = 0.f;
            const v4u* yr = (const v4u*)(y + (size_t)m * D) + lane;
#pragma unroll
            for (int j = 0; j < 8; ++j) unpack8f(yr[64 * j], yv[2 * j], yv[2 * j + 1]);
#pragma unroll
            for (int j = 0; j < 16; ++j) ss += (yv[j].x * yv[j].x + yv[j].y * yv[j].y) + (yv[j].z * yv[j].z + yv[j].w * yv[j].w);
            const float rstd = 1.0f / sqrtf(wave_sum(ss) * (1.0f / D) + EPS);
#pragma unroll
            for (int j = 0; j < 8; ++j) {
#pragma unroll
                for (int k = 0; k < 2; ++k) { const f32x4 g = ((const f32x4*)gpost)[2 * lane + 128 * j + k]; xv[2 * j + k] = xv[2 * j + k] + yv[2 * j + k] * rstd * g; } }
        }
        if (out32) { f32x4* xo = (f32x4*)(out32 + (size_t)m * D) + 2 * lane;
#pragma unroll
            for (int j = 0; j < 8; ++j) { xo[128 * j] = xv[2 * j]; xo[128 * j + 1] = xv[2 * j + 1]; } }
        if (xb_out) {
            float s2 = 0.f;
#pragma unroll
            for (int j = 0; j < 16; ++j) s2 += (xv[j].x * xv[j].x + xv[j].y * xv[j].y) + (xv[j].z * xv[j].z + xv[j].w * xv[j].w);
            const float ms = wave_sum(s2) * (1.0f / D) + EPS; const float rs2 = 1.0f / sqrtf(ms);
            v4u* o16 = (v4u*)(XBo + (size_t)m * D) + lane;
#pragma unroll
            for (int j = 0; j < 8; ++j) { const f32x4 a = xv[2 * j] * rs2, b = xv[2 * j + 1] * rs2; v4u w; w.x = pk2(a.x, a.y); w.y = pk2(a.z, a.w); w.z = pk2(b.x, b.y); w.w = pk2(b.z, b.w); o16[64 * j] = w; }
            if (A8) { v2u* o8 = (v2u*)(A8 + (size_t)m * D) + lane; const float s8 = rs2 * A8_SCALE;
#pragma unroll
                for (int j = 0; j < 8; ++j) { const f32x4 a = xv[2 * j] * s8, b = xv[2 * j + 1] * s8; v2u w; w.x = pk4_fp8(a.x, a.y, a.z, a.w); w.y = pk4_fp8(b.x, b.y, b.z, b.w); o8[64 * j] = w; } }
            if (lane == 0) RNo[m] = sqrtf(ms); }
    }
}

__device__ __forceinline__ void gates_phase(const bf16* XN, const bf16* Wg, float* GATES, LAS unsigned char* lds, int gw, int ngw, int wave, int lane) {
    LAS f32x4* red = (LAS f32x4*)lds;
    for (int u = gw; u < M / 8; u += ngw) {
        const int row0 = (u >> 1) * 16, kh = u & 1; f32x4 acc0 = (f32x4){0.f, 0.f, 0.f, 0.f}, acc1 = acc0;
        const bf16* ap = XN + (size_t)(row0 + (lane & 15)) * D + kh * (D / 2) + (lane >> 4) * 8;
        const bf16* bp = Wg + (size_t)(lane & 15) * D + kh * (D / 2) + (lane >> 4) * 8;
#pragma unroll 1
        for (int kb = 0; kb < 4; ++kb) {
            bf16x8 a[16], b[16];
#pragma unroll
            for (int kk = 0; kk < 16; ++kk) { a[kk] = *(const bf16x8*)(ap + (kb * 16 + kk) * 32); b[kk] = *(const bf16x8*)(bp + (kb * 16 + kk) * 32); }
#pragma unroll
            for (int kk = 0; kk < 16; kk += 2) { acc0 = __builtin_amdgcn_mfma_f32_16x16x32_bf16(a[kk], b[kk], acc0, 0, 0, 0); acc1 = __builtin_amdgcn_mfma_f32_16x16x32_bf16(a[kk + 1], b[kk + 1], acc1, 0, 0, 0); }
        }
        f32x4 s = acc0 + acc1;
        if (kh) red[(wave >> 1) * 64 + lane] = s;
        __syncthreads();
        if (!kh) { s += red[(wave >> 1) * 64 + lane];
#pragma unroll
            for (int r = 0; r < 4; ++r) GATES[(size_t)(row0 + 4 * (lane >> 4) + r) * 16 + (lane & 15)] = s[r]; }
        __syncthreads();
    }
}

__device__ __forceinline__ float gelu_tanh(float x) { return x * sigm(1.5957691216057308f * (x + 0.044715f * x * x * x)); }

struct TItem { const float* W; int N, nsrc0, k0, n0; unsigned char* dst; int pitchB, esz; const float* gk; float scale; };
__device__ __forceinline__ void titem_load(const TItem& I, f32x4 (&v)[8], int lane) {
    const int r8 = lane >> 3, c4 = (lane & 7) * 4;
#pragma unroll
    for (int i = 0; i < 8; ++i) v[i] = *(const f32x4*)(I.W + (size_t)(I.k0 + 8 * i + r8) * I.N + I.nsrc0 + I.n0 + c4);
}
__device__ __forceinline__ void titem_to_lds(const f32x4 (&v)[8], LAS float* scr, int lane) {
    const int r8 = lane >> 3, c4 = (lane & 7) * 4;
#pragma unroll
    for (int i = 0; i < 8; ++i) { LAS float* d = scr + (8 * i + r8) * 33 + c4; d[0] = v[i].x; d[1] = v[i].y; d[2] = v[i].z; d[3] = v[i].w; }
}
__device__ __forceinline__ void titem_store(const TItem& I, LAS float* scr, int lane) {
    const int c = lane & 7;
    f32x4 ga = (f32x4){I.scale, I.scale, I.scale, I.scale}, gb = ga; if (I.gk) { ga = *(const f32x4*)(I.gk + I.k0 + 8 * c) * I.scale; gb = *(const f32x4*)(I.gk + I.k0 + 8 * c + 4) * I.scale; }
#pragma unroll
    for (int j = 0; j < 4; ++j) { const int n = (lane >> 3) + 8 * j; const LAS float* s = scr + (8 * c) * 33 + n;
        const float e0 = s[0 * 33] * ga.x, e1 = s[1 * 33] * ga.y, e2 = s[2 * 33] * ga.z, e3 = s[3 * 33] * ga.w, e4 = s[4 * 33] * gb.x, e5 = s[5 * 33] * gb.y, e6 = s[6 * 33] * gb.z, e7 = s[7 * 33] * gb.w;
        unsigned char* d = I.dst + (size_t)(I.n0 + n) * I.pitchB + (size_t)(I.k0 + 8 * c) * I.esz;
        if (I.esz == 2) { v4u o; o.x = pk2(e0, e1); o.y = pk2(e2, e3); o.z = pk2(e4, e5); o.w = pk2(e6, e7); *(v4u*)d = o; }
        else { v2u o; o.x = pk4_fp8(e0, e1, e2, e3); o.y = pk4_fp8(e4, e5, e6, e7); *(v2u*)d = o; } }
}
__device__ __forceinline__ void prep_phase(const Params& p, int l, LAS unsigned char* lds, int bid, int G, int wave, int lane) {
    LAS float* scr = (LAS float*)(lds + wave * 16384);
    const int gw = bid * NWAVES + wave, NGW = G * NWAVES;
    const float* g_mix = p.in[1] + (size_t)l * D; const float* g_mlp = p.in[3] + (size_t)l * D;
    const float* w_in = p.in[5] + (size_t)l * D * PW; const float* p_a = p.in[10] + (size_t)l * MW * D; const float* w_glu = p.in[19] + (size_t)l * S5W * S5W;
    const float* p_b = p.in[21] + (size_t)l * S5W * D; const float* w_out = p.in[22] + (size_t)l * D * D; const float* w_ff1 = p.in[23] + (size_t)l * D * DFF; const float* w_ff2 = p.in[24] + (size_t)l * DFF * D;
    unsigned char* ws = p.ws; bf16* WIN = (bf16*)(ws + WS_WIN);
    constexpr int I_IN1 = (D / 64) * (6144 / 32), I_IN2 = (D / 64) * (1024 / 32), I_IN8 = (D / 64) * (8192 / 32), I_PA = (MW / 64) * (D / 32), I_GLU = (S5W / 64) * (S5W / 32), I_PB = (S5W / 64) * (D / 32),
                  I_OUT = (D / 64) * (D / 32), I_FF1 = (D / 64) * (DFF / 32), I_FF2 = (DFF / 64) * (D / 32);
    constexpr int NITEMS = I_IN1 + I_IN2 + I_IN8 + I_PA + I_GLU + I_PB + I_OUT + I_FF1 + I_FF2;
#define TI(W_, N_, nsrc_, nblk_, dst_, pitchB_, esz_, koffB_, gk_, sc_) do { I.W = (W_); I.N = (N_); I.nsrc0 = (nsrc_); I.k0 = 64 * (r / (nblk_)); I.n0 = 32 * (r % (nblk_)); I.dst = (dst_) + (koffB_); I.pitchB = (pitchB_); I.esz = (esz_); I.gk = (gk_); I.scale = (sc_); } while (0)
    auto decode = [&](int it, TItem& I) { int r = NITEMS - 1 - it;
        if (r < I_IN1) { TI(w_in, PW, 0, 192, ws + WS_WIN, D * 2, 2, 0, g_mix, 1.f); return; } r -= I_IN1;
        if (r < I_IN2) { TI(w_in, PW, 6160, 32, ws + WS_WIN + (size_t)6144 * D * 2, D * 2, 2, 0, g_mix, 1.f); return; } r -= I_IN2;
        if (r < I_IN8) { TI(w_in, PW, 7184, 256, ws + WS_W8, D, 1, 0, g_mix, W8_SCALE); return; } r -= I_IN8;
        if (r < I_PA) { TI(p_a, D, 0, 128, ws + WS_WPA, HZW * 2, 2, 0, nullptr, 1.f); return; } r -= I_PA;
        if (r < I_GLU) { TI(w_glu, S5W, 0, 32, ws + WS_WGLU, S5W * 2, 2, 0, nullptr, 1.f); return; } r -= I_GLU;
        if (r < I_PB) { TI(p_b, D, 0, 128, ws + WS_WPA, HZW * 2, 2, MW * 2, nullptr, 1.f); return; } r -= I_PB;
        if (r < I_OUT) { TI(w_out, D, 0, 128, ws + WS_WOUT, D * 2, 2, 0, nullptr, 1.f); return; } r -= I_OUT;
        if (r < I_FF1) { TI(w_ff1, DFF, 0, 512, ws + WS_WFF1, D * 2, 2, 0, g_mlp, 1.f); return; } r -= I_FF1;
        TI(w_ff2, D, 0, 128, ws + WS_WFF2, DFF * 2, 2, 0, nullptr, 1.f); };
    if (gw < NITEMS) {
        TItem cur, nxt; f32x4 v[8];
        decode(gw, cur); titem_load(cur, v, lane);
        for (int it = gw; it < NITEMS; it += NGW) {
            titem_to_lds(v, scr, lane);
            const bool more = it + NGW < NITEMS;
            if (more) { decode(it + NGW, nxt); titem_load(nxt, v, lane); }
            LDS_WAIT(); asm volatile("" ::: "memory");
            titem_store(cur, scr, lane);
            LDS_WAIT(); asm volatile("" ::: "memory");
            if (more) cur = nxt;
        }
    }
#undef TI
    for (int e = bid * 512 + (int)threadIdx.x; e < 16 * D; e += G * 512) { const int j = e & 15, k = e >> 4; WIN[(size_t)(NP + j) * D + k] = (bf16)(pk2(w_in[(size_t)k * PW + 6144 + j] * g_mix[k], 0.f) & 0xffffu); }
    if (l == 0) resid_rows(p.in[0], (bf16*)(p.ws + WS_XN), nullptr, nullptr, true, nullptr, (float*)(p.ws + WS_RS), gw, NGW, lane, nullptr, nullptr, p.ws + WS_A8);
}

typedef short s16x4 __attribute__((ext_vector_type(4)));
#define MFMA16(a, b, c) __builtin_amdgcn_mfma_f32_16x16x32_bf16(a, b, c, 0, 0, 0)
constexpr int ML_QI = 0, ML_KI = 17408, ML_VI = 34816, ML_PI = 70656, ML_EB = 79872, ML_EKW = 81920, ML_EG = 83968, ML_LG = 84000, ML_HT = 84480, ML_GN = 151040;
constexpr int QSTR = 272, VSTR = 560, PSTR = 144, HSTR = 260;
constexpr size_t ST_UNIT = 139264;
constexpr size_t WS_STG = WS_ST + 256 * ST_UNIT;
static_assert(WS_STG + 4096 <= WS_END, "ws map");
constexpr size_t WS_QKC = WS_Y32;
constexpr size_t WS_ST2 = WS_Y32 + 64 * MiB;

__device__ __forceinline__ bf16x8 tr_frag(const LAS unsigned char* p0, const LAS unsigned char* p1) {
    const s16x4 a = __builtin_amdgcn_ds_read_tr16_b64_v4i16((LAS s16x4*)p0), b = __builtin_amdgcn_ds_read_tr16_b64_v4i16((LAS s16x4*)p1);
    return __builtin_shufflevector(a, b, 0, 1, 2, 3, 4, 5, 6, 7);
}
__device__ __forceinline__ bf16x8 pack8(const f32x4 a, const f32x4 b) { v4u w; w.x = pk2(a.x, a.y); w.y = pk2(a.z, a.w); w.z = pk2(b.x, b.y); w.w = pk2(b.z, b.w); return __builtin_bit_cast(bf16x8, w); }

template <bool FULL>
__device__ __forceinline__ void mlstm_unit(const Params& p, int l, int unit, LAS unsigned char* lds, int tid_, int lane_, int wave) {
    int tid = tid_; asm volatile("" : "+v"(tid));
    const int lane = tid & 63; (void)lane_;
    const int b = unit >> 7, h = (unit >> 4) & 7, seg = unit & 15;
    const bf16* QK = (const bf16*)(p.ws + WS_QK); const bf16* V = (const bf16*)(p.ws + WS_V); const float* GATES = (const float*)(p.ws + WS_GATES);
    bf16* QKC = (bf16*)(p.ws + WS_QKC); const bf16* SO = (const bf16*)(p.ws + WS_SO); bf16* HG = (bf16*)(p.ws + WS_HG);
    float* STC = (float*)(p.ws + WS_ST + (size_t)unit * ST_UNIT); float* STG = (float*)(p.ws + WS_STG);
    LAS float* EB = (LAS float*)(lds + ML_EB); LAS float* EKW = (LAS float*)(lds + ML_EKW); LAS float* EG = (LAS float*)(lds + ML_EG); LAS float* LG = (LAS float*)(lds + ML_LG);
    LAS float* HT = (LAS float*)(lds + ML_HT);
    const int g4 = lane >> 4, q4 = (lane & 15) >> 2, p4 = lane & 3, c16 = lane & 15;
    const size_t rowb = (size_t)b * SEQ; const int t0 = seg * 512;
    { const size_t row = rowb + t0 + wave * 64 + lane;
      const float ip = GATES[row * 16 + h] + p.in[7][l * 8 + h], fp = GATES[row * 16 + 8 + h] + p.in[8][l * 8 + h];
      float bsum = -log1pf(__expf(-fp));
#pragma unroll
      for (int o = 1; o < 64; o <<= 1) { const float t = __shfl_up(bsum, o); if (lane >= o) bsum += t; }
      EB[wave * 64 + lane] = __expf(bsum); EKW[wave * 64 + lane] = __expf(ip - bsum);
      if (lane == 63) { EG[wave] = __expf(bsum); LG[wave] = bsum; } }
    f32x4 Cacc[8][3];
#pragma unroll
    for (int i = 0; i < 8; ++i)
#pragma unroll
        for (int j = 0; j < 3; ++j) Cacc[i][j] = (f32x4){0.f, 0.f, 0.f, 0.f};
    if (FULL && seg > 0) {
        const float* sj = (const float*)(p.ws + WS_ST2 + (size_t)unit * ST_UNIT);
#pragma unroll
        for (int i = 0; i < 8; ++i) {
#pragma unroll
            for (int n = 0; n < 2; ++n) Cacc[i][n] = *(const f32x4*)(sj + ((size_t)(i * 2 + n) * 512 + tid) * 4);
            Cacc[i][2] = *(const f32x4*)(sj + 32768 + ((size_t)i * 64 + lane) * 4);
        }
    }
    const int which = tid >> 8, sb = (tid >> 7) & 1, dch = tid & 127, ch = which * 1024 + h * 128 + dch;
    float cw0 = 0.f, cw1 = 0.f, cw2 = 0.f, cw3 = 0.f;
    if (!FULL) { const float* cw = p.in[6] + (size_t)l * 4 * 2048; cw0 = cw[ch]; cw1 = cw[2048 + ch]; cw2 = cw[4096 + ch]; cw3 = cw[6144 + ch]; }
    const int vrow = tid >> 3, vc8 = (tid & 7) * 8;
    unsigned short rawh[FULL ? 1 : 35]; v4u qkr[FULL ? 4 : 1]; v4u vr[4];
#define ML_LOAD(c_) do { const size_t Rl = rowb + t0 + (c_) * 64; \
        if (!FULL) { const int tq0 = t0 + (c_) * 64 + 32 * sb - 3; _Pragma("unroll") for (int i = 0; i < 35; ++i) rawh[i] = (tq0 + i >= 0) ? QK[(rowb + tq0 + i) * 2048 + ch] : (unsigned short)0; } \
        else { _Pragma("unroll") for (int i = 0; i < 2; ++i) { const int col = i * 64 + vc8; qkr[i] = *(const v4u*)(QKC + (Rl + vrow) * 2048 + h * 128 + col); qkr[2 + i] = *(const v4u*)(QKC + (Rl + vrow) * 2048 + 1024 + h * 128 + col); } } \
        _Pragma("unroll") for (int i = 0; i < 4; ++i) vr[i] = *(const v4u*)(V + (Rl + vrow) * 2048 + h * 256 + i * 64 + vc8); } while (0)
    ML_LOAD(0);
    if (FULL) { if (tid < 256) ((LAS float*)(lds + ML_GN))[tid] = p.in[9][(size_t)l * MW + h * 256 + tid]; }
    if ((tid & 7) == 0) { const v4u z = (v4u){0u, 0u, 0u, 0u}; *(LAS v4u*)(lds + ML_VI + vrow * VSTR + 512) = z; *(LAS v4u*)(lds + ML_VI + vrow * VSTR + 528) = z; }
    __syncthreads();
#pragma unroll 1
    for (int c = 0; c < 8; ++c) {
        const size_t Rc = rowb + t0 + c * 64;
        int tz = tid; asm volatile("" : "+v"(tz));
        const int lane = tz & 63, g4 = lane >> 4, q4 = (lane & 15) >> 2, p4 = lane & 3, c16 = lane & 15, vrow = tz >> 3, vc8 = (tz & 7) * 8, dch = tz & 127, sb = (tz >> 7) & 1;
        if (!FULL) {
#pragma unroll
            for (int s2 = 0; s2 < 32; ++s2) {
                const float a = cw0 * bf2f(rawh[s2]) + cw1 * bf2f(rawh[s2 + 1]) + cw2 * bf2f(rawh[s2 + 2]) + cw3 * bf2f(rawh[s2 + 3]);
                float val = a * sigm(a); if (!which) val *= 0.08838834764831845f;
                const bf16 bv = (bf16)(pk2(val, 0.f) & 0xffffu);
                QKC[(Rc + 32 * sb + s2) * 2048 + ch] = bv;
                if (which) *(LAS bf16*)(lds + ML_KI + (32 * sb + s2) * QSTR + dch * 2) = bv;
            }
        } else {
#pragma unroll
            for (int i = 0; i < 2; ++i) { const int col = i * 64 + vc8;
                *(LAS v4u*)(lds + ML_QI + vrow * QSTR + col * 2) = qkr[i];
                *(LAS v4u*)(lds + ML_KI + vrow * QSTR + col * 2) = qkr[2 + i]; }
        }
        { const float ek = EKW[c * 64 + vrow];
#pragma unroll
          for (int i = 0; i < 4; ++i) { const int col = i * 64 + vc8; const v4u w = vr[i];
              v4u o; o.x = pk2(__uint_as_float(w.x << 16) * ek, __uint_as_float(w.x & 0xffff0000u) * ek); o.y = pk2(__uint_as_float(w.y << 16) * ek, __uint_as_float(w.y & 0xffff0000u) * ek);
              o.z = pk2(__uint_as_float(w.z << 16) * ek, __uint_as_float(w.z & 0xffff0000u) * ek); o.w = pk2(__uint_as_float(w.w << 16) * ek, __uint_as_float(w.w & 0xffff0000u) * ek);
              *(LAS v4u*)(lds + ML_VI + vrow * VSTR + col * 2) = o; }
          if ((tid & 7) == 0) *(LAS bf16*)(lds + ML_VI + vrow * VSTR + 512) = (bf16)(pk2(ek, 0.f) & 0xffffu); }
        __syncthreads();
        if (!FULL) { if (c + 1 < 8) ML_LOAD(c + 1); }
        if (FULL) {
            const int mt = wave >> 1, ntb = 2 * (wave & 1);
            f32x4 sacc[2] = {(f32x4){0.f, 0.f, 0.f, 0.f}, (f32x4){0.f, 0.f, 0.f, 0.f}};
#pragma unroll
            for (int ks = 0; ks < 4; ++ks) { const bf16x8 a = *(const LAS bf16x8*)(lds + ML_QI + (16 * mt + c16) * QSTR + (32 * ks + 8 * g4) * 2);
#pragma unroll
                for (int n2 = 0; n2 < 2; ++n2) { const bf16x8 bb = *(const LAS bf16x8*)(lds + ML_KI + (16 * (ntb + n2) + c16) * QSTR + (32 * ks + 8 * g4) * 2); sacc[n2] = MFMA16(a, bb, sacc[n2]); } }
#pragma unroll
            for (int n2 = 0; n2 < 2; ++n2)
#pragma unroll
                for (int r = 0; r < 4; ++r) { const int t = 16 * mt + 4 * g4 + r, s = 16 * (ntb + n2) + c16;
                    const float val = (s <= t) ? sacc[n2][r] * EB[c * 64 + t] : 0.f;
                    *(LAS bf16*)(lds + ML_PI + t * PSTR + s * 2) = (bf16)(pk2(val, 0.f) & 0xffffu); }
            __syncthreads();
        }
        bf16x8 bV[2][3];
#pragma unroll
        for (int ks = 0; ks < 2; ++ks)
#pragma unroll
            for (int n = 0; n < 3; ++n) { const int col0 = (n < 2) ? (32 * wave + 16 * n) : 256;
                const LAS unsigned char* a0 = lds + ML_VI + (32 * ks + 8 * g4 + q4) * VSTR + (col0 + 4 * p4) * 2;
                bV[ks][n] = tr_frag(a0, a0 + 4 * VSTR); }
        if (FULL) {
            int tzm = tid; asm volatile("" : "+v"(tzm)); const int lane = tzm & 63, g4 = lane >> 4, q4 = (lane & 15) >> 2, p4 = lane & 3, c16 = lane & 15, vrow = tzm >> 3, vc8 = (tzm & 7) * 8; (void)q4; (void)p4; (void)c16; (void)vrow; (void)vc8; (void)g4;
            bf16x8 Cb[4][3];
#pragma unroll
            for (int ks = 0; ks < 4; ++ks)
#pragma unroll
                for (int n = 0; n < 3; ++n) Cb[ks][n] = pack8(Cacc[2 * ks][n], Cacc[2 * ks + 1][n]);
#pragma unroll 2
            for (int m = 0; m < 4; ++m) {
                f32x4 nacc[3] = {(f32x4){0.f, 0.f, 0.f, 0.f}, (f32x4){0.f, 0.f, 0.f, 0.f}, (f32x4){0.f, 0.f, 0.f, 0.f}};
#pragma unroll
                for (int ks = 0; ks < 4; ++ks) {
                    const s16x4 lo = *(const LAS s16x4*)(lds + ML_QI + (16 * m + c16) * QSTR + (32 * ks + 4 * g4) * 2), hi = *(const LAS s16x4*)(lds + ML_QI + (16 * m + c16) * QSTR + (32 * ks + 16 + 4 * g4) * 2);
                    const bf16x8 a = __builtin_shufflevector(lo, hi, 0, 1, 2, 3, 4, 5, 6, 7);
#pragma unroll
                    for (int n = 0; n < 3; ++n) nacc[n] = MFMA16(a, Cb[ks][n], nacc[n]);
                }
#pragma unroll
                for (int r = 0; r < 4; ++r) { const float e = EB[c * 64 + 16 * m + 4 * g4 + r];
#pragma unroll
                    for (int n = 0; n < 3; ++n) nacc[n][r] *= e; }
#pragma unroll
                for (int ks = 0; ks < 2; ++ks) { const bf16x8 a = *(const LAS bf16x8*)(lds + ML_PI + (16 * m + c16) * PSTR + (32 * ks + 8 * g4) * 2);
#pragma unroll
                    for (int n = 0; n < 3; ++n) nacc[n] = MFMA16(a, bV[ks][n], nacc[n]); }
#pragma unroll
                for (int r = 0; r < 4; ++r) { const float dn = __shfl(nacc[2][r], lane & 48); const float inv = 1.0f / fmaxf(fabsf(dn), 1.0f);
                    LAS float* hp = HT + (16 * m + 4 * g4 + r) * HSTR + 32 * wave + c16;
                    hp[0] = nacc[0][r] * inv; hp[16] = nacc[1][r] * inv; }
            }
        }
        {   int tzu = tid; asm volatile("" : "+v"(tzu)); const int lane = tzu & 63, g4 = lane >> 4, q4 = (lane & 15) >> 2, p4 = lane & 3, c16 = lane & 15, vrow = tzu >> 3, vc8 = (tzu & 7) * 8; (void)q4; (void)p4; (void)c16; (void)vrow; (void)vc8; (void)g4;
#pragma unroll
        for (int ks = 0; ks < 2; ++ks)
#pragma unroll
            for (int i = 0; i < 8; ++i) { const LAS unsigned char* a0 = lds + ML_KI + (32 * ks + 8 * g4 + q4) * QSTR + (16 * i + 4 * p4) * 2;
                const bf16x8 a = tr_frag(a0, a0 + 4 * QSTR);
#pragma unroll
                for (int n = 0; n < 3; ++n) Cacc[i][n] = MFMA16(a, bV[ks][n], Cacc[i][n]);
                if ((i & 3) == 3) __builtin_amdgcn_sched_barrier(0); }
        { const float eg = EG[c];
#pragma unroll
          for (int i = 0; i < 8; ++i)
#pragma unroll
              for (int n = 0; n < 3; ++n) Cacc[i][n] *= eg; }
        if (FULL) { if (c + 1 < 8) ML_LOAD(c + 1); }
        }
        __syncthreads();
        if (FULL) {
            int tzh = tid; asm volatile("" : "+v"(tzh)); const int lane = tzh & 63, g4 = lane >> 4, q4 = (lane & 15) >> 2, p4 = lane & 3, c16 = lane & 15, vrow = tzh >> 3, vc8 = (tzh & 7) * 8; (void)q4; (void)p4; (void)c16; (void)vrow; (void)vc8; (void)g4;
            const int t = 8 * wave + (lane >> 3), part = lane & 7;
            v4u sog[4];
            { const bf16* sp = SO + (Rc + t) * MW + h * 256 + part * 32;
#pragma unroll
              for (int i = 0; i < 4; ++i) sog[i] = *(const v4u*)(sp + 8 * i); }
            float s1 = 0.f, s2 = 0.f;
#pragma unroll
            for (int i = 0; i < 8; ++i) { const f32x4 x = *(const LAS f32x4*)(HT + t * HSTR + part * 32 + i * 4); s1 += (x.x + x.y) + (x.z + x.w); s2 += (x.x * x.x + x.y * x.y) + (x.z * x.z + x.w * x.w); }
#pragma unroll
            for (int o = 1; o < 8; o <<= 1) { s1 += __shfl_xor(s1, o); s2 += __shfl_xor(s2, o); }
            const float mean = s1 * (1.0f / 256.0f); const float var = fmaxf(s2 * (1.0f / 256.0f) - mean * mean, 0.f); const float rs = 1.0f / sqrtf(var + EPS);
            const size_t offh = (Rc + t) * HZW + h * 256 + part * 32; const LAS float* gp = (const LAS float*)(lds + ML_GN) + part * 32;
#pragma unroll
            for (int i = 0; i < 4; ++i) { const v4u so = sog[i]; f32x4 sa, sb; { sa = (f32x4){__uint_as_float(so.x << 16), __uint_as_float(so.x & 0xffff0000u), __uint_as_float(so.y << 16), __uint_as_float(so.y & 0xffff0000u)}; sb = (f32x4){__uint_as_float(so.z << 16), __uint_as_float(so.z & 0xffff0000u), __uint_as_float(so.w << 16), __uint_as_float(so.w & 0xffff0000u)}; }
                const f32x4 ga = *(const LAS f32x4*)(gp + 8 * i), gb = *(const LAS f32x4*)(gp + 8 * i + 4);
                const f32x4 va = *(const LAS f32x4*)(HT + t * HSTR + part * 32 + 8 * i), vb = *(const LAS f32x4*)(HT + t * HSTR + part * 32 + 8 * i + 4);
                const f32x4 oa = (va - mean) * rs * ga * sa, ob = (vb - mean) * rs * gb * sb;
                v4u w; w.x = pk2(oa.x, oa.y); w.y = pk2(oa.z, oa.w); w.z = pk2(ob.x, ob.y); w.w = pk2(ob.z, ob.w);
                *(v4u*)(HG + offh + 8 * i) = w; }
        }
    }
#undef ML_LOAD
    if (!FULL) {
#pragma unroll
        for (int i = 0; i < 8; ++i) {
#pragma unroll
            for (int n = 0; n < 2; ++n) *(f32x4*)(STC + ((size_t)(i * 2 + n) * 512 + tid) * 4) = Cacc[i][n];
            if (wave == 0) *(f32x4*)(STC + 32768 + ((size_t)i * 64 + lane) * 4) = Cacc[i][2];
        }
        if (tid == 0) { float s = 0.f;
#pragma unroll
            for (int c = 0; c < 8; ++c) s += LG[c];
            STG[unit] = s; }
    }
    __syncthreads();
}

__device__ __forceinline__ void mlstm_carry(const Params& p, int bid, int G) {
    const float* STG = (const float*)(p.ws + WS_STG);
    constexpr int NV4 = (int)(ST_UNIT / 16);
    for (int e = bid * 512 + (int)threadIdx.x; e < 16 * NV4; e += G * 512) {
        const int chain = e / NV4, i = e % NV4;
        f32x4 S = (f32x4){0.f, 0.f, 0.f, 0.f};
        f32x4 cl[15];
#pragma unroll
        for (int s = 0; s < 15; ++s) cl[s] = *((const f32x4*)(p.ws + WS_ST + (size_t)(chain * 16 + s) * ST_UNIT) + i);
        float eg[15];
#pragma unroll
        for (int s = 0; s < 15; ++s) eg[s] = STG[chain * 16 + s];
        asm volatile("" ::: "memory");
#pragma unroll
        for (int s = 0; s < 15; ++s) { S = __expf(eg[s]) * S + cl[s]; *((f32x4*)(p.ws + WS_ST2 + (size_t)(chain * 16 + s + 1) * ST_UNIT) + i) = S; }
    }
}


constexpr size_t WS_S5T = WS_END, WS_S5C = WS_S5T + 8 * MiB, WS_S5B = WS_S5C + 4 * MiB, WS_S5L = WS_S5B + 4 * MiB, WS_END2 = WS_S5L + 1 * MiB;
static_assert(WS_END2 <= WS_A8, "ws map");
constexpr size_t WS_XL = WS_Y32 + 100 * MiB;
constexpr size_t WS_XP = WS_Y32 + 132 * MiB;
constexpr int TSTR = 528, CSTR = 272;

__device__ __forceinline__ void s5_matrices(const Params& p, int l, int g, LAS unsigned char* lds, int tid) {
    LAS float* LPr = (LAS float*)lds; LAS float* LPi = LPr + 17 * 64; LAS float* Bbr = LPi + 17 * 64; LAS float* Bbi = Bbr + 1024;
    LAS float* Cr = Bbi + 1024; LAS float* Ci = Cr + 1024; LAS float* KM = Ci + 1024;
    const int lg = l * S5G + g;
    if (tid < 64) {
        const float lre = fminf(p.in[11][lg * 64 + tid], -1e-4f), lim = p.in[12][lg * 64 + tid], dt = expf(p.in[13][lg]);
        const float mag = expf(lre * dt), ang = lim * dt; const float br = mag * cosf(ang), bi = mag * sinf(ang);
        const float den = lre * lre + lim * lim, nr = br - 1.0f; const float rr = (nr * lre + bi * lim) / den, ri = (bi * lre - nr * lim) / den;
        float pr = 1.f, pi = 0.f;
        for (int t = 0; t <= 16; ++t) { LPr[t * 64 + tid] = pr; LPi[t * 64 + tid] = pi; const float a = pr * br - pi * bi, b2 = pr * bi + pi * br; pr = a; pi = b2; }
        const float* bre = p.in[14] + ((size_t)lg * 64 + tid) * 16; const float* bim = p.in[15] + ((size_t)lg * 64 + tid) * 16;
        for (int m = 0; m < 16; ++m) { const float b_r = bre[m], b_i = bim[m]; Bbr[tid * 16 + m] = rr * b_r - ri * b_i; Bbi[tid * 16 + m] = rr * b_i + ri * b_r; }
    }
    for (int e = tid; e < 1024; e += 512) { Cr[e] = p.in[16][(size_t)lg * 1024 + e]; Ci[e] = p.in[17][(size_t)lg * 1024 + e]; }
    __syncthreads();
    if (tid < 64) ((float2*)(p.ws + WS_S5L))[g * 64 + tid] = make_float2(LPr[16 * 64 + tid], LPi[16 * 64 + tid]);
    for (int e = tid; e < 4096; e += 512) { const int tau = e >> 8, n = (e >> 4) & 15, m = e & 15; float acc = 0.f;
        for (int q = 0; q < 64; ++q) { const float cr = Cr[n * 64 + q], ci = Ci[n * 64 + q], lr = LPr[tau * 64 + q], li = LPi[tau * 64 + q];
            const float clr = cr * lr - ci * li, cli = cr * li + ci * lr; acc += clr * Bbr[q * 16 + m] - cli * Bbi[q * 16 + m]; }
        KM[e] = acc; }
    __syncthreads();
    bf16* TO = (bf16*)(p.ws + WS_S5T) + (size_t)g * 65536; bf16* CPm = (bf16*)(p.ws + WS_S5C) + (size_t)g * 32768; bf16* BPm = (bf16*)(p.ws + WS_S5B) + (size_t)g * 32768;
    for (int ck = tid; ck < 8192; ck += 512) { const int row = ck >> 5, k0 = (ck & 31) * 8, s = k0 >> 4, m0 = k0 & 15, t = row >> 4, n = row & 15; float v[8];
#pragma unroll
        for (int e = 0; e < 8; ++e) v[e] = (s <= t) ? KM[(t - s) * 256 + n * 16 + m0 + e] : 0.f;
        v4u o; o.x = pk2(v[0], v[1]); o.y = pk2(v[2], v[3]); o.z = pk2(v[4], v[5]); o.w = pk2(v[6], v[7]); *(v4u*)(TO + (size_t)row * 256 + k0) = o; }
    for (int ck = tid; ck < 4096; ck += 512) { const int row = ck >> 4, k0 = (ck & 15) * 8, part = k0 >> 6, p0 = k0 & 63, t = row >> 4, n = row & 15; float v[8];
#pragma unroll
        for (int e = 0; e < 8; ++e) { const int q = p0 + e; const float cr = Cr[n * 64 + q], ci = Ci[n * 64 + q], lr = LPr[(t + 1) * 64 + q], li = LPi[(t + 1) * 64 + q]; v[e] = part ? -(cr * li + ci * lr) : (cr * lr - ci * li); }
        v4u o; o.x = pk2(v[0], v[1]); o.y = pk2(v[2], v[3]); o.z = pk2(v[4], v[5]); o.w = pk2(v[6], v[7]); *(v4u*)(CPm + (size_t)row * 128 + k0) = o; }
    for (int ck = tid; ck < 4096; ck += 512) { const int row = ck >> 5, k0 = (ck & 31) * 8, s = k0 >> 4, m0 = k0 & 15, part = row >> 6, q = row & 63, tau = 15 - s; float v[8];
        const float lr = LPr[tau * 64 + q], li = LPi[tau * 64 + q];
#pragma unroll
        for (int e = 0; e < 8; ++e) { const float b_r = Bbr[q * 16 + m0 + e], b_i = Bbi[q * 16 + m0 + e]; v[e] = part ? (lr * b_i + li * b_r) : (lr * b_r - li * b_i); }
        v4u o; o.x = pk2(v[0], v[1]); o.y = pk2(v[2], v[3]); o.z = pk2(v[4], v[5]); o.w = pk2(v[6], v[7]); *(v4u*)(BPm + (size_t)row * 256 + k0) = o; }
    __syncthreads();
}

__device__ __forceinline__ void s5_local(const Params& p, int unit, LAS unsigned char* lds, int tid_, int wave) {
    int tid = tid_; asm volatile("" : "+v"(tid));
    const int lane = tid & 63, g4 = lane >> 4, c16 = lane & 15;
    const int chain = unit >> 1, hf = unit & 1, b = chain >> 6, g = chain & 63;
    const bf16* U = (const bf16*)(p.ws + WS_U); float* XL = (float*)(p.ws + WS_XL);
    { const unsigned char* src = p.ws + WS_S5B + (size_t)g * 65536;
#pragma unroll
      for (int i = 0; i < 8; ++i) { const int ck = tid + 512 * i, row = ck >> 5, kc = ck & 31; *(LAS v4u*)(lds + row * TSTR + kc * 16) = *(const v4u*)(src + row * 512 + kc * 16); } }
    __syncthreads();
    f32x4 acc[8][2];
#pragma unroll
    for (int i = 0; i < 8; ++i) { acc[i][0] = (f32x4){0.f, 0.f, 0.f, 0.f}; acc[i][1] = (f32x4){0.f, 0.f, 0.f, 0.f}; }
    const int blk0 = 16 * (hf * 16 + 2 * wave) + c16;
#pragma unroll
    for (int ks = 0; ks < 8; ++ks) {
        bf16x8 bfr[2];
#pragma unroll
        for (int n2 = 0; n2 < 2; ++n2) bfr[n2] = *(const bf16x8*)(U + ((size_t)chain * SEQ + (blk0 + 16 * n2) * 16 + 2 * ks + (g4 >> 1)) * 16 + 8 * (g4 & 1));
#pragma unroll
        for (int mt = 0; mt < 8; ++mt) { const bf16x8 a = *(const LAS bf16x8*)(lds + (16 * mt + c16) * TSTR + (32 * ks + 8 * g4) * 2);
            acc[mt][0] = MFMA16(a, bfr[0], acc[mt][0]); acc[mt][1] = MFMA16(a, bfr[1], acc[mt][1]); }
    }
#pragma unroll
    for (int mt = 0; mt < 8; ++mt)
#pragma unroll
        for (int n2 = 0; n2 < 2; ++n2) *(f32x4*)(XL + ((size_t)chain * 512 + blk0 + 16 * n2) * 128 + 16 * mt + 4 * g4) = acc[mt][n2];
    __syncthreads();
}

__device__ __forceinline__ void s5_scan(const Params& p, int chain, LAS unsigned char* lds, int tid_, int wave) {
    int tid = tid_; asm volatile("" : "+v"(tid));
    const int lane = tid & 63, g = chain & 63;
    const float* XL = (const float*)(p.ws + WS_XL) + (size_t)chain * 512 * 128 + (size_t)(64 * wave) * 128 + lane; bf16* XP = (bf16*)(p.ws + WS_XP) + (size_t)chain * 512 * 128 + (size_t)(64 * wave) * 128 + lane;
    LAS float* Esr = (LAS float*)lds; LAS float* Esi = Esr + 512;
    float er[32], ei[32];
#define S5_LOAD_HALF(h) do { _Pragma("unroll") for (int j = 0; j < 32; ++j) { er[j] = XL[(32 * (h) + j) * 128]; ei[j] = XL[(32 * (h) + j) * 128 + 64]; } } while (0)
    S5_LOAD_HALF(1);
    asm volatile("" ::: "memory");
    const float2 lam = ((const float2*)(p.ws + WS_S5L))[g * 64 + lane];
    float x1r = er[0], x1i = ei[0];
#pragma unroll
    for (int j = 1; j < 32; ++j) { const float nr = lam.x * x1r - lam.y * x1i + er[j], ni = lam.x * x1i + lam.y * x1r + ei[j]; x1r = nr; x1i = ni; }
    asm volatile("" ::: "memory");
    S5_LOAD_HALF(0);
    float xr = er[0], xi = ei[0];
#pragma unroll
    for (int j = 1; j < 32; ++j) { const float nr = lam.x * xr - lam.y * xi + er[j], ni = lam.x * xi + lam.y * xr + ei[j]; xr = nr; xi = ni; }
    float pr = lam.x, pi = lam.y;
#pragma unroll
    for (int k = 0; k < 5; ++k) { const float nr = pr * pr - pi * pi, ni = 2.f * pr * pi; pr = nr; pi = ni; }
    Esr[wave * 64 + lane] = pr * xr - pi * xi + x1r; Esi[wave * 64 + lane] = pr * xi + pi * xr + x1i;
    __syncthreads();
    { const float nr = pr * pr - pi * pi, ni = 2.f * pr * pi; pr = nr; pi = ni; }
    xr = 0.f; xi = 0.f;
    for (int j = 0; j < wave; ++j) { const float ex = Esr[j * 64 + lane], ey = Esi[j * 64 + lane]; const float nr = pr * xr - pi * xi + ex, ni = pr * xi + pi * xr + ey; xr = nr; xi = ni; }
#pragma unroll
    for (int h = 0; h < 2; ++h) {
        if (h == 1) { asm volatile("" ::: "memory"); S5_LOAD_HALF(1); }
#pragma unroll
        for (int j = 0; j < 32; ++j) { XP[(32 * h + j) * 128] = (bf16)(pk2(xr, 0.f) & 0xffffu); XP[(32 * h + j) * 128 + 64] = (bf16)(pk2(xi, 0.f) & 0xffffu);
            const float nr = lam.x * xr - lam.y * xi + er[j], ni = lam.x * xi + lam.y * xr + ei[j]; xr = nr; xi = ni; }
    }
#undef S5_LOAD_HALF
    __syncthreads();
}

__device__ __forceinline__ void s5_final(const Params& p, int l, int unit, LAS unsigned char* lds, int tid_, int wave) {
    int tid = tid_; asm volatile("" : "+v"(tid));
    const int lane = tid & 63, g4 = lane >> 4, c16 = lane & 15;
    const int chain = unit >> 1, h2 = unit & 1, b = chain >> 6, g = chain & 63;
    const bf16* U = (const bf16*)(p.ws + WS_U); bf16* Z = (bf16*)(p.ws + WS_Z); const bf16* XP = (const bf16*)(p.ws + WS_XP) + (size_t)chain * 512 * 128;
    LAS unsigned char* ldT = lds; LAS unsigned char* ldC = lds + 128 * TSTR;
    { const unsigned char* srcT = p.ws + WS_S5T + (size_t)g * 131072 + (size_t)h2 * 128 * 512; const unsigned char* srcC = p.ws + WS_S5C + (size_t)g * 65536 + (size_t)h2 * 128 * 256;
#pragma unroll
      for (int i = 0; i < 8; ++i) { const int ck = tid + 512 * i, row = ck >> 5, kc = ck & 31; *(LAS v4u*)(ldT + row * TSTR + kc * 16) = *(const v4u*)(srcT + row * 512 + kc * 16); }
#pragma unroll
      for (int i = 0; i < 4; ++i) { const int ck = tid + 512 * i, row = ck >> 4, kc = ck & 15; *(LAS v4u*)(ldC + row * CSTR + kc * 16) = *(const v4u*)(srcC + row * 256 + kc * 16); } }
    float dsk[4];
#pragma unroll
    for (int r = 0; r < 4; ++r) dsk[r] = p.in[18][l * S5W + g * 16 + 4 * g4 + r];
    __syncthreads();
    const int nks = h2 ? 8 : 4;
#pragma unroll 1
    for (int np = 0; np < 2; ++np) {
        f32x4 acc[8][2];
#pragma unroll
        for (int i = 0; i < 8; ++i) { acc[i][0] = (f32x4){0.f, 0.f, 0.f, 0.f}; acc[i][1] = (f32x4){0.f, 0.f, 0.f, 0.f}; }
        const int blk0 = 16 * (4 * wave + 2 * np) + c16;
        bf16x8 bu[8][2], bx[4][2];
#pragma unroll
        for (int ks = 0; ks < 8; ++ks)
#pragma unroll
            for (int n2 = 0; n2 < 2; ++n2) if (ks < nks) bu[ks][n2] = *(const bf16x8*)(U + ((size_t)chain * SEQ + (blk0 + 16 * n2) * 16 + 2 * ks + (g4 >> 1)) * 16 + 8 * (g4 & 1));
#pragma unroll
        for (int ks = 0; ks < 4; ++ks)
#pragma unroll
            for (int n2 = 0; n2 < 2; ++n2) bx[ks][n2] = *(const bf16x8*)(XP + (size_t)(blk0 + 16 * n2) * 128 + 32 * ks + 8 * g4);
#pragma unroll
        for (int ks = 0; ks < 8; ++ks) if (ks < nks) {
#pragma unroll
            for (int mt = 0; mt < 8; ++mt) { const bf16x8 a = *(const LAS bf16x8*)(ldT + (16 * mt + c16) * TSTR + (32 * ks + 8 * g4) * 2);
                acc[mt][0] = MFMA16(a, bu[ks][0], acc[mt][0]); acc[mt][1] = MFMA16(a, bu[ks][1], acc[mt][1]); }
        }
#pragma unroll
        for (int ks = 0; ks < 4; ++ks) {
#pragma unroll
            for (int mt = 0; mt < 8; ++mt) { const bf16x8 a = *(const LAS bf16x8*)(ldC + (16 * mt + c16) * CSTR + (32 * ks + 8 * g4) * 2);
                acc[mt][0] = MFMA16(a, bx[ks][0], acc[mt][0]); acc[mt][1] = MFMA16(a, bx[ks][1], acc[mt][1]); }
        }
        v2u uus[8][2];
#pragma unroll
        for (int mt = 0; mt < 8; ++mt)
#pragma unroll
            for (int n2 = 0; n2 < 2; ++n2) uus[mt][n2] = *(const v2u*)(U + ((size_t)chain * SEQ + (blk0 + 16 * n2) * 16 + 8 * h2 + mt) * 16 + 4 * g4);
        asm volatile("" ::: "memory");
#pragma unroll
        for (int mt = 0; mt < 8; ++mt)
#pragma unroll
            for (int n2 = 0; n2 < 2; ++n2) { const size_t row = (size_t)b * SEQ + (blk0 + 16 * n2) * 16 + 8 * h2 + mt; const size_t off = row * S5W + g * 16 + 4 * g4;
                const v2u uu = uus[mt][n2];
                const float u4[4] = {__uint_as_float(uu.x << 16), __uint_as_float(uu.x & 0xffff0000u), __uint_as_float(uu.y << 16), __uint_as_float(uu.y & 0xffff0000u)};
                float z[4];
#pragma unroll
                for (int r = 0; r < 4; ++r) z[r] = gelu_tanh(acc[mt][n2][r] + dsk[r] * u4[r]);
                v2u w; w.x = pk2(z[0], z[1]); w.y = pk2(z[2], z[3]); *(v2u*)(Z + off) = w; }
    }
    __syncthreads();
}

__device__ __forceinline__ void layer_body(const Params& p, const int l, LAS unsigned char* lds, const XcdBarrier& bar, int wave, int G, int bid, int gw, int NGW) {
    unsigned char* ws = p.ws;
    bf16* XN = (bf16*)(ws + WS_XN); float* RS = (float*)(ws + WS_RS);
    bf16* Y16 = (bf16*)(ws + WS_Y32);

#define IN(k) (((MK_PH_MASK >> (k)) & 1) && p.ph_lo <= (k) && (k) < p.ph_hi)
#define NREP(k) ((((MK_DUP_MASK) >> (k)) & 1) ? 2 : 1)
#define FRESH() int tid = (int)threadIdx.x; asm volatile("" : "+v"(tid)); const int lane = tid & 63; (void)lane
#define SEAM(k) do { if (!(l == p.l_hi - 1 && (k) == p.ph_hi - 1)) xcd_barrier(bar); } while (0)
        if (IN(0)) { FRESH(); for (int g = bid; g < S5G; g += G) s5_matrices(p, l, g, lds, tid); _Pragma("unroll") for (int rep = 0; rep < NREP(0); ++rep) { prep_phase(p, l, lds, bid, G, wave, lane); __syncthreads(); } SEAM(0); }
        if (IN(1)) {
            { pg8::Gemm g{XN, (const bf16*)(ws + WS_WIN), M, 7168, D}; pg8::StaticOrder S; S.init(M, 7168, G, bid);
              pg8::EpiB<0> E{nullptr, 0, nullptr, nullptr, nullptr, (bf16*)(ws + WS_QK), (bf16*)(ws + WS_V), (bf16*)(ws + WS_SO), (bf16*)(ws + WS_U), (bf16*)(ws + WS_SGA), (bf16*)(ws + WS_SGB)};
              _Pragma("unroll") for (int rep = 0; rep < NREP(1); ++rep) pg8::gemm_phase<pg8::EpiB<0>, pg8::StaticOrder, true, true>(lds, g, S, E); }
            { FRESH(); gates_phase(XN, (const bf16*)(ws + WS_WIN) + (size_t)NP * D, (float*)(ws + WS_GATES), lds, gw, NGW, wave, lane); }
            SEAM(1);
        }
        if (IN(2)) {
            FRESH();
            _Pragma("unroll") for (int rep = 0; rep < 1 + MK_DUP_ML1; ++rep) {
            for (int unit = bid; unit < 256; unit += G) mlstm_unit<false>(p, l, unit, lds, tid, lane, wave);
            __syncthreads(); }
            _Pragma("unroll") for (int rep = 0; rep < 1 + MK_DUP_S51; ++rep) {
            for (int unit = bid; unit < 256; unit += G) s5_local(p, unit, lds, tid, wave);
            __syncthreads(); }
            SEAM(2);
        }
        if (IN(3)) { FRESH();
            if (G >= 256) { if (bid >= 128) mlstm_carry(p, bid - 128, G - 128); else s5_scan(p, bid, lds, tid, wave); }
            else { mlstm_carry(p, bid, G); for (int chain = bid; chain < 128; chain += G) s5_scan(p, chain, lds, tid, wave); }
            SEAM(3); }
        if (IN(4)) {
            FRESH();
            _Pragma("unroll") for (int rep = 0; rep < 1 + MK_DUP_ML2; ++rep) {
            for (int unit = bid; unit < 256; unit += G) mlstm_unit<true>(p, l, unit, lds, tid, lane, wave);
            __syncthreads(); }
            _Pragma("unroll") for (int rep = 0; rep < 1 + MK_DUP_S52; ++rep) {
            for (int unit = bid; unit < 256; unit += G) s5_final(p, l, unit, lds, tid, wave);
            __syncthreads(); }
            SEAM(4);
        }
        if (IN(5)) {
            pg8::Gemm g{(const bf16*)(ws + WS_Z), (const bf16*)(ws + WS_WGLU), M, S5W, S5W}; pg8::StaticOrder S; S.init(M, S5W, G, bid);
            pg8::EpiB<2> E{(bf16*)(ws + WS_HG) + MW, HZW, (const bf16*)(ws + WS_Z), nullptr, p.in[20] + (size_t)l * S5W, nullptr, nullptr, nullptr, nullptr, nullptr, nullptr, S5W};
            _Pragma("unroll") for (int rep = 0; rep < NREP(5); ++rep) pg8::gemm_phase<pg8::EpiB<2>, pg8::StaticOrder, true, true>(lds, g, S, E);
            { pg8::Gemm g{(const bf16*)(ws + WS_A8), (const bf16*)(ws + WS_W8), M, 8192, D / 2}; pg8::StaticOrder S; S.init(M, 8192, G, bid);
              pg8::EpiGate8 E{ws + WS_SG8A, ws + WS_SG8B, 1.0f / (A8_SCALE * W8_SCALE)};
              pg8::gemm_phase<pg8::EpiGate8, pg8::StaticOrder, true, true, 0, 0, false, true>(lds, g, S, E); }
            SEAM(5);
        }
        if (IN(6)) {
            pg8::Gemm g{(const bf16*)(ws + WS_HG), (const bf16*)(ws + WS_WPA), M, D, HZW, MW / 64}; pg8::StaticOrder S; S.init(M, D, G, bid);
            pg8::EpiMerge E{(bf16*)(ws + WS_SGA), ws + WS_SG8A, ws + WS_SG8B, D};
            pg8::gemm_phase<pg8::EpiMerge, pg8::StaticOrder, true, true, 0, 0, true>(lds, g, S, E);
            SEAM(6);
        }
        if (IN(7)) {
            pg8::Gemm g{(const bf16*)(ws + WS_SGA), (const bf16*)(ws + WS_WOUT), M, D, D}; pg8::StaticOrder S; S.init(M, D, G, bid);
            pg8::EpiB<5> E{Y16, D, nullptr, nullptr, nullptr, nullptr, nullptr, nullptr, nullptr, nullptr, nullptr};
            _Pragma("unroll") for (int rep = 0; rep < NREP(7); ++rep) pg8::gemm_phase<pg8::EpiB<5>, pg8::StaticOrder, true, true>(lds, g, S, E);
            SEAM(7);
        }
        if (IN(8)) { FRESH(); resid_rows(nullptr, XN, Y16, p.in[2] + (size_t)l * D, true, nullptr, RS, gw, NGW, lane); SEAM(8); }
        if (IN(9)) {
            pg8::Gemm g{XN, (const bf16*)(ws + WS_WFF1), M, DFF, D}; pg8::StaticOrder S; S.init(M, DFF, G, bid);
            pg8::EpiB<1> E{(bf16*)(ws + WS_H1), DFF, nullptr, nullptr, nullptr, nullptr, nullptr, nullptr, nullptr, nullptr, nullptr};
            _Pragma("unroll") for (int rep = 0; rep < NREP(9); ++rep) pg8::gemm_phase<pg8::EpiB<1>, pg8::StaticOrder, true, true>(lds, g, S, E);
            SEAM(9);
        }
        if (IN(10)) {
            pg8::Gemm g{(const bf16*)(ws + WS_H1), (const bf16*)(ws + WS_WFF2), M, D, DFF}; pg8::StaticOrder S; S.init(M, D, G, bid);
            pg8::EpiB<5> E{Y16, D, nullptr, nullptr, nullptr, nullptr, nullptr, nullptr, nullptr, nullptr, nullptr};
            _Pragma("unroll") for (int rep = 0; rep < NREP(10); ++rep) pg8::gemm_phase<pg8::EpiB<5>, pg8::StaticOrder, true, true, MK_FF2_AUXA, 0>(lds, g, S, E);
            SEAM(10);
        }
        if (IN(11)) { FRESH(); resid_rows(nullptr, XN, Y16, p.in[4] + (size_t)l * D, l + 1 < DEPTH, (l + 1 < DEPTH) ? nullptr : p.out, RS, gw, NGW, lane, nullptr, nullptr, ws + WS_A8); __syncthreads(); }
#undef IN
#undef SEAM
}

__global__ void __launch_bounds__(NWAVES * 64, 2) mk_fwd(Params p) {
    extern __shared__ __attribute__((aligned(16))) unsigned char lds_raw[];
    LAS unsigned char* lds = (LAS unsigned char*)lds_raw;
    const int tid = threadIdx.x, lane = tid & 63, wave = __builtin_amdgcn_readfirstlane(tid >> 6);
    const int G = gridDim.x, bid = blockIdx.x;
    const int gw = bid * NWAVES + wave, NGW = G * NWAVES;
    for (int u = tid; u < (LDS_BYTES - LDSCTL_OFF) / 4; u += NWAVES * 64) ((LAS unsigned*)(lds + LDSCTL_OFF))[u] = 0u;
    __syncthreads();
    unsigned* ctl = (unsigned*)(p.ws + WS_CTL);
    XcdBarrier bar = xcd_barrier_post(ctl + CW_BAR + p.li * XCD_BAR_WORDS, (volatile LAS unsigned*)(lds + MISC_OFF) + 8);
    if (p.l_lo <= 0 && 0 < p.l_hi) layer_body(p, 0, lds, bar, wave, G, bid, gw, NGW);
    if (p.l_lo <= 1 && 1 < p.l_hi) layer_body(p, 1, lds, bar, wave, G, bid, gw, NGW);
}

extern "C" void kernel_launch(void* const* d_in, const int* in_sizes, int n_in, void* d_out, int out_size, void* d_ws, size_t ws_size, hipStream_t stream) {
    static int grid = 0;
    if (grid == 0) {
        if (n_in != 25 || in_sizes[0] != M * D || out_size != M * D || ws_size < WS_END3) { fprintf(stderr, "kernel_launch: unexpected shapes (n_in %d, in0 %d, out %d, ws %zu); nothing launched\n", n_in, n_in > 0 ? in_sizes[0] : -1, out_size, ws_size); grid = -1; return; }
        int dev = 0, cus = 0, per_cu = 0;
        if (hipGetDevice(&dev) != hipSuccess || hipDeviceGetAttribute(&cus, hipDeviceAttributeMultiprocessorCount, dev) != hipSuccess) { grid = -1; return; }
        if (hipFuncSetAttribute((const void*)mk_fwd, hipFuncAttributeMaxDynamicSharedMemorySize, LDS_BYTES) != hipSuccess) { fprintf(stderr, "kernel_launch: hipFuncSetAttribute failed\n"); grid = -1; return; }
        if (hipOccupancyMaxActiveBlocksPerMultiprocessor(&per_cu, (const void*)mk_fwd, NWAVES * 64, LDS_BYTES) != hipSuccess || per_cu < 1) { fprintf(stderr, "kernel_launch: occupancy query says %d blocks per CU\n", per_cu); }
        (void)hipGetLastError();
        grid = cus;
    }
    if (grid < 0) return;
    if (hipMemsetAsync((char*)d_ws + WS_CTL, 0, CTL_ZERO_BYTES, stream) != hipSuccess) { fprintf(stderr, "kernel_launch: memset failed\n"); return; }
    Params a{};
    for (int i = 0; i < 25; ++i) a.in[i] = (const float*)d_in[i];
    a.out = (float*)d_out; a.ws = (unsigned char*)d_ws; a.pad = 0;
#if MK_ONE_LAUNCH
    a.l_lo = 0; a.l_hi = DEPTH; a.ph_lo = 0; a.ph_hi = NPH; a.li = 0;
    hipLaunchKernelGGL(mk_fwd, dim3(grid), dim3(NWAVES * 64), LDS_BYTES, stream, a);
#else
    for (int l = 0; l < DEPTH; ++l)
        for (int ph = 0; ph < NPH; ++ph) { a.l_lo = l; a.l_hi = l + 1; a.ph_lo = ph; a.ph_hi = ph + 1; a.li = 0;
            hipLaunchKernelGGL(mk_fwd, dim3(grid), dim3(NWAVES * 64), LDS_BYTES, stream, a); }
#endif
    const hipError_t le = hipPeekAtLastError();
    if (le != hipSuccess) fprintf(stderr, "kernel_launch: launch failed: %s\n", hipGetErrorName(le));
}
```

```cpp
#include <hip/hip_runtime.h>
#include <cstdio>
#include <cstdint>

#ifndef MK_PH_MASK
#define MK_PH_MASK 0xfff
#endif
#ifndef MK_DUP_MASK
#define MK_DUP_MASK 0x000
#endif
#ifndef MK_DUP_ML1
#define MK_DUP_ML1 0
#endif
#ifndef MK_DUP_S51
#define MK_DUP_S51 0
#endif
#ifndef MK_DUP_ML2
#define MK_DUP_ML2 0
#endif
#ifndef MK_DUP_S52
#define MK_DUP_S52 0
#endif
#ifndef MK_FF2_AUXA
#define MK_FF2_AUXA 0
#endif
#ifndef MK_NT_STORE
#define MK_NT_STORE 0
#endif
#ifndef MK_DUP_EPI
#define MK_DUP_EPI 0
#endif
#ifndef MK_ONE_LAUNCH
#define MK_ONE_LAUNCH 1
#endif

namespace pg8 {
#define PG8_LAS __attribute__((address_space(3)))
typedef unsigned short bf16_t;
typedef short bf16x8 __attribute__((ext_vector_type(8)));
typedef float f32x4 __attribute__((ext_vector_type(4)));
typedef unsigned u32x4 __attribute__((ext_vector_type(4)));
typedef int v8i_t __attribute__((ext_vector_type(8)));
typedef short s16x16_t __attribute__((ext_vector_type(16)));
constexpr int BM = 256, BK = 64, HALF = 128, HTB = HALF * BK * 2  , STAGE_BYTES = 8 * HTB, NXCD = 8, WGM = 8;

__host__ __device__ __forceinline__ int lds_byte(int r, int c) { const int st = (r >> 4) * 2 + (c >> 5), rr = r & 15, cc = c & 31, ob = rr * 64 + cc * 2; return st * 1024 + (ob ^ (((ob >> 9) & 1) << 5)); }
__host__ __device__ __forceinline__ void stage_rc(int b, int& R, int& C) { const int st = b / 1024, sb = b % 1024, swz = sb ^ (((sb >> 9) & 1) << 5); R = (st >> 1) * 16 + swz / 64; C = (st & 1) * 32 + (swz % 64) / 2; }
__host__ __device__ __forceinline__ int perm32(int rho) { const int n = rho >> 4, i = rho & 15; return 8 * (i >> 2) + 4 * n + (i & 3); }

struct Unit { int pm, pn; };
struct Gemm { const bf16_t* A; const bf16_t* Bt; int M, N, K; int ksplit; };

struct StaticOrder {
    int nM, nN, nwg, G, c;
    __host__ __device__ void init(int M, int N, int G_, int c_) { nM = M / BM; nN = N / BM; nwg = nM * nN; G = G_; c = c_; }
    __host__ __device__ bool next(int i, Unit& u) const {
        const long L = (long)i * G + c; if (L >= nwg) return false;
        int wgid = (int)L; { const int q = nwg / NXCD, r = nwg % NXCD, xcd = wgid % NXCD, off = wgid / NXCD; wgid = (xcd < r ? xcd * (q + 1) : r * (q + 1) + (xcd - r) * q) + off; }
        const int nig = WGM * nN, gid = wgid / nig, fm = gid * WGM, gsz = (nM - fm) < WGM ? (nM - fm) : WGM;
        u.pm = fm + ((wgid % nig) % gsz); u.pn = (wgid % nig) / gsz; return true;
    }
    __device__ __forceinline__ void a_ready(const Unit&) const {}
    __device__ __forceinline__ void done(const Unit&) const {}
};

__device__ __forceinline__ unsigned cvt_pk_bf16(float lo, float hi) { unsigned r; asm volatile("s_nop 0\n\tv_cvt_pk_bf16_f32 %0, %1, %2" : "=v"(r) : "v"(lo), "v"(hi)); return r; }
__device__ __forceinline__ float sigm(float x) { return __builtin_amdgcn_rcpf(1.0f + __builtin_amdgcn_exp2f(-1.44269504f * x)); }
__device__ __forceinline__ f32x4 sigm4(f32x4 v) { return (f32x4){sigm(v[0]), sigm(v[1]), sigm(v[2]), sigm(v[3])}; }
__device__ __forceinline__ void unpack8(const u32x4 w, f32x4& a, f32x4& b) {
    a = (f32x4){__uint_as_float(w.x << 16), __uint_as_float(w.x & 0xffff0000u), __uint_as_float(w.y << 16), __uint_as_float(w.y & 0xffff0000u)};
    b = (f32x4){__uint_as_float(w.z << 16), __uint_as_float(w.z & 0xffff0000u), __uint_as_float(w.w << 16), __uint_as_float(w.w & 0xffff0000u)};
}

struct EpiF32 {
    static constexpr bool PERM = false, AFTER_DRAIN = false;
    float* C; int ldc;
    __device__ __forceinline__ void operator()(const f32x4 (&acc)[2][2][4][2], const Unit& u, int wr, int wc, int fr, int fq) const {
        const int row0 = u.pm * BM + wr * 64 + fr, col0 = u.pn * BM + wc * 32 + 4 * fq;
#pragma unroll
        for (int ai = 0; ai < 2; ++ai)
#pragma unroll
            for (int m = 0; m < 4; ++m) { float* rowp = C + (size_t)(row0 + ai * HALF + m * 16) * ldc + col0;
#pragma unroll
                for (int bj = 0; bj < 2; ++bj)
#pragma unroll
                    for (int n = 0; n < 2; ++n) *(f32x4*)(rowp + bj * HALF + n * 16) = acc[ai][bj][m][n]; }
    }
};
template <int MODE> struct EpiB {
    static constexpr bool PERM = true, AFTER_DRAIN = false;
    bf16_t* O; int ldc; const bf16_t* X1; const bf16_t* X2; const float* bias;
    bf16_t *pQK, *pV, *pSO, *pU, *pGA, *pGB;
    int ldx;
    __device__ __forceinline__ void operator()(const f32x4 (&acc)[2][2][4][2], const Unit& u, int wr, int wc, int fr, int fq) const {
        bf16_t* base = O; int ld = ldc; int colt = u.pn * BM; bool act = false, isU = false;
        if (MODE == 0) {
            const int pn = u.pn;
            if (pn < 8) { base = pQK; ld = 2048; colt = pn * BM; }
            else if (pn < 16) { base = pV; ld = 2048; colt = (pn - 8) * BM; }
            else if (pn < 24) { base = pSO; ld = 2048; colt = (pn - 16) * BM; act = true; }
            else if (pn < 28) { base = pU; ld = 1024; colt = (pn - 24) * BM; isU = true; }
            else if (pn < 44) { base = pGA; ld = 4096; colt = (pn - 28) * BM; act = true; }
            else { base = pGB; ld = 4096; colt = (pn - 44) * BM; act = true; }
        }
        const int row0 = u.pm * BM + wr * 64 + fr, col0 = colt + wc * 32 + 8 * fq;
        u32x4 lx[(MODE == 2) ? 2 : 1][4][2];
        if (MODE == 2) {
#pragma unroll
            for (int ai = 0; ai < 2; ++ai)
#pragma unroll
                for (int m = 0; m < 4; ++m)
#pragma unroll
                    for (int bj = 0; bj < 2; ++bj) lx[ai][m][bj] = *(const u32x4*)(X1 + (size_t)(row0 + ai * HALF + m * 16) * ldx + col0 + bj * HALF);
            asm volatile("" ::: "memory"); }
#pragma unroll
        for (int ai = 0; ai < 2; ++ai)
#pragma unroll
            for (int m = 0; m < 4; ++m) { const size_t ro = (size_t)(row0 + ai * HALF + m * 16) * ld + col0;
#pragma unroll
                for (int bj = 0; bj < 2; ++bj) { f32x4 v0 = acc[ai][bj][m][0], v1 = acc[ai][bj][m][1]; size_t o = ro + bj * HALF;
                    if (MODE == 0) { if (act) { v0 = sigm4(v0); v1 = sigm4(v1); }
                        if (isU) { const int row = row0 + ai * HALF + m * 16, col = col0 + bj * HALF; o = ((size_t)((row >> 13) * 64 + (col >> 4)) * 8192 + (row & 8191)) * 16 + (col & 8); } }
                    if (MODE == 1) { v0 = __builtin_elementwise_max(v0, (f32x4){0.f, 0.f, 0.f, 0.f}); v1 = __builtin_elementwise_max(v1, (f32x4){0.f, 0.f, 0.f, 0.f}); v0 = v0 * v0; v1 = v1 * v1; }
                    if (MODE == 2) { const float* bp = bias + col0 + bj * HALF; const f32x4 b0 = *(const f32x4*)bp, b1 = *(const f32x4*)(bp + 4);
                        f32x4 x0, x1; unpack8(lx[(MODE == 2) ? ai : 0][m][bj], x0, x1); v0 = x0 * sigm4(v0 + b0); v1 = x1 * sigm4(v1 + b1); }
                    if (MODE == 3) { f32x4 x0, x1; unpack8(*(const u32x4*)(X1 + o), x0, x1); v0 = x0 * v0; v1 = x1 * v1; }
                    if (MODE == 4) { f32x4 x0, x1, y0, y1; unpack8(*(const u32x4*)(X1 + o), x0, x1); unpack8(*(const u32x4*)(X2 + o), y0, y1); v0 = x0 + y0 * v0; v1 = x1 + y1 * v1; }
                    u32x4 w; w.x = cvt_pk_bf16(v0[0], v0[1]); w.y = cvt_pk_bf16(v0[2], v0[3]); w.z = cvt_pk_bf16(v1[0], v1[1]); w.w = cvt_pk_bf16(v1[2], v1[3]);
                    if (MK_NT_STORE && (MODE == 0 || MODE == 1)) __builtin_nontemporal_store(w, (u32x4*)(base + o)); else *(u32x4*)(base + o) = w; } }
    }
};

__device__ __forceinline__ unsigned gate_q4(f32x4 v, float scale) {
    unsigned q[4];
#pragma unroll
    for (int j = 0; j < 4; ++j) { const float t = __builtin_fmaf(255.0f, sigm(v[j] * scale), 0.5f); const unsigned u = (unsigned)t; q[j] = u < 1u ? 1u : u; }
    return q[0] | (q[1] << 8) | (q[2] << 16) | (q[3] << 24);
}
__device__ __forceinline__ f32x4 gate_u4(unsigned w) { return (f32x4){(float)(w & 0xffu), (float)((w >> 8) & 0xffu), (float)((w >> 16) & 0xffu), (float)(w >> 24)}; }
struct EpiGate8 {
    static constexpr bool PERM = true, AFTER_DRAIN = false;
    unsigned char* pGA; unsigned char* pGB; float scale;
    __device__ __forceinline__ void operator()(const f32x4 (&acc)[2][2][4][2], const Unit& u, int wr, int wc, int fr, int fq) const {
        unsigned char* base = (u.pn < 16) ? pGA : pGB; const int colt = (u.pn & 15) * BM;
        const int row0 = u.pm * BM + wr * 64 + fr, col0 = colt + wc * 64 + 16 * fq;
#pragma unroll
        for (int ai = 0; ai < 2; ++ai)
#pragma unroll
            for (int m = 0; m < 4; ++m) { u32x4 w;
                w.x = gate_q4(acc[ai][0][m][0], scale); w.y = gate_q4(acc[ai][0][m][1], scale); w.z = gate_q4(acc[ai][1][m][0], scale); w.w = gate_q4(acc[ai][1][m][1], scale);
                *(u32x4*)(base + (size_t)(row0 + ai * HALF + m * 16) * 4096 + col0) = w; }
    }
};

struct EpiMerge {
    static constexpr bool PERM = true, AFTER_DRAIN = false;
    bf16_t* O; const unsigned char* SGA; const unsigned char* SGB; int ldc;
    __device__ __forceinline__ void mid(f32x4 (&acc)[2][2][4][2], const Unit& u, int wr, int wc, int fr, int fq) const {
        const int row0 = u.pm * BM + wr * 64 + fr, col0 = u.pn * BM + wc * 64 + 16 * fq;
        u32x4 la[2][4], lb[2][4];
#pragma unroll
        for (int ai = 0; ai < 2; ++ai)
#pragma unroll
            for (int m = 0; m < 4; ++m) { const size_t o = (size_t)(row0 + ai * HALF + m * 16) * 4096 + col0; la[ai][m] = *(const u32x4*)(SGA + o); lb[ai][m] = *(const u32x4*)(SGB + o); }
        asm volatile("" ::: "memory");
#pragma unroll
        for (int ai = 0; ai < 2; ++ai)
#pragma unroll
            for (int m = 0; m < 4; ++m)
#pragma unroll
                for (int bj = 0; bj < 2; ++bj) { const f32x4 a0 = gate_u4(la[ai][m][2 * bj]), a1 = gate_u4(la[ai][m][2 * bj + 1]), b0 = gate_u4(lb[ai][m][2 * bj]), b1 = gate_u4(lb[ai][m][2 * bj + 1]);
#pragma unroll
                    for (int j = 0; j < 4; ++j) { acc[ai][bj][m][0][j] *= a0[j] * __builtin_amdgcn_rcpf(b0[j]); acc[ai][bj][m][1][j] *= a1[j] * __builtin_amdgcn_rcpf(b1[j]); } }
        asm volatile("" ::: "memory");
    }
    __device__ __forceinline__ void operator()(const f32x4 (&acc)[2][2][4][2], const Unit& u, int wr, int wc, int fr, int fq) const {
        const int row0 = u.pm * BM + wr * 64 + fr, col0 = u.pn * BM + wc * 32 + 8 * fq, colg = u.pn * BM + wc * 64 + 16 * fq;
        u32x4 lb[2][4];
#pragma unroll
        for (int ai = 0; ai < 2; ++ai)
#pragma unroll
            for (int m = 0; m < 4; ++m) lb[ai][m] = *(const u32x4*)(SGB + (size_t)(row0 + ai * HALF + m * 16) * 4096 + colg);
        asm volatile("" ::: "memory");
#pragma unroll
        for (int ai = 0; ai < 2; ++ai)
#pragma unroll
            for (int m = 0; m < 4; ++m)
#pragma unroll
                for (int bj = 0; bj < 2; ++bj) { const size_t o = (size_t)(row0 + ai * HALF + m * 16) * ldc + col0 + bj * HALF;
                    const f32x4 v0 = acc[ai][bj][m][0] * (gate_u4(lb[ai][m][2 * bj]) * (1.0f / 255.0f)), v1 = acc[ai][bj][m][1] * (gate_u4(lb[ai][m][2 * bj + 1]) * (1.0f / 255.0f));
                    u32x4 w; w.x = cvt_pk_bf16(v0[0], v0[1]); w.y = cvt_pk_bf16(v0[2], v0[3]); w.z = cvt_pk_bf16(v1[0], v1[1]); w.w = cvt_pk_bf16(v1[2], v1[3]);
                    *(u32x4*)(O + o) = w; }
    }
};

template <class Epi, class Sched, bool ALIGN_EPI = false, bool SP2 = false, int AUXA = 0, int AUXB = 0, bool SPLIT = false, bool FP8 = false>
__device__ __forceinline__ void gemm_phase(PG8_LAS unsigned char* lds, const Gemm g, const Sched& S, const Epi& E) {
    int tid_ = threadIdx.x; asm volatile("" : "+v"(tid_));
    const int tid = tid_, wid = __builtin_amdgcn_readfirstlane(tid >> 6), lane = tid & 63, wr = wid >> 2, wc = wid & 3, fr = lane & 15, fq = lane >> 4;
    const int K = g.K; int nt = K / BK;
    unsigned voffA[2], voffB[2];
#pragma unroll
    for (int i = 0; i < 2; ++i) { int R, C; stage_rc(tid * 16 + i * 8192, R, C); const int Rb = Epi::PERM ? ((R & ~31) + perm32(R & 31)) : R;
        voffA[i] = (unsigned)(R * K + C) * 2u; voffB[i] = (unsigned)(Rb * K + C) * 2u; }
    const size_t kstep = (size_t)(BK * 2);
    const size_t hstep = (size_t)HALF * K * 2;
    const size_t tstep = 2 * hstep;
    const unsigned ldsw = (unsigned)wid * 1024u;
    const int aoff = FP8 ? lds_byte(wr * 64 + fr, fq * 16) : lds_byte(wr * 64 + fr, fq * 8), boff = FP8 ? lds_byte(wc * 32 + fr, fq * 16) : lds_byte(wc * 32 + fr, fq * 8);
#define PG8_SA(b, h) (((b) * 2 + (h)) * HTB)
#define PG8_SB(b, h) ((4 + (b) * 2 + (h)) * HTB)
#define PG8_STAGE(bufoff, gbase, voff, aux) do { _Pragma("unroll") for (int _i = 0; _i < 2; ++_i) \
        __builtin_amdgcn_global_load_lds((const unsigned*)((const char*)(gbase) + (voff)[_i]), (PG8_LAS unsigned*)(lds + (bufoff) + ldsw + _i * 8192), 16, 0, aux); } while (0)
#define PG8_LDA(dst, b, h) do { if constexpr (FP8) { _Pragma("unroll") for (int m = 0; m < 4; ++m) { const bf16x8 _p0 = *(const PG8_LAS bf16x8*)(lds + PG8_SA(b, h) + aoff + m * 2048), _p1 = *(const PG8_LAS bf16x8*)(lds + PG8_SA(b, h) + aoff + m * 2048 + 16); dst##8[m] = __builtin_bit_cast(v8i_t, __builtin_shufflevector(_p0, _p1, 0, 1, 2, 3, 4, 5, 6, 7, 8, 9, 10, 11, 12, 13, 14, 15)); } } else _Pragma("unroll") for (int m = 0; m < 4; ++m) _Pragma("unroll") for (int k = 0; k < 2; ++k) dst[m][k] = *(const PG8_LAS bf16x8*)(lds + PG8_SA(b, h) + aoff + m * 2048 + k * 1024); } while (0)
#define PG8_LDB(dst, b, h) do { if constexpr (FP8) { _Pragma("unroll") for (int n = 0; n < 2; ++n) { const bf16x8 _p0 = *(const PG8_LAS bf16x8*)(lds + PG8_SB(b, h) + boff + n * 2048), _p1 = *(const PG8_LAS bf16x8*)(lds + PG8_SB(b, h) + boff + n * 2048 + 16); dst##8[n] = __builtin_bit_cast(v8i_t, __builtin_shufflevector(_p0, _p1, 0, 1, 2, 3, 4, 5, 6, 7, 8, 9, 10, 11, 12, 13, 14, 15)); } } else _Pragma("unroll") for (int n = 0; n < 2; ++n) _Pragma("unroll") for (int k = 0; k < 2; ++k) dst[n][k] = *(const PG8_LAS bf16x8*)(lds + PG8_SB(b, h) + boff + n * 2048 + k * 1024); } while (0)
#define PG8_MMA(ai, bj, At, Bt) do { __builtin_amdgcn_s_setprio(1); if constexpr (FP8) { _Pragma("unroll") for (int m = 0; m < 4; ++m) _Pragma("unroll") for (int n = 0; n < 2; ++n) { asm volatile("v_mfma_scale_f32_16x16x128_f8f6f4 %0, %1, %2, %0, %3, %3 op_sel_hi:[0,0,0]" : "+v"(acc[ai][bj][m][n]) : "v"(Bt##8[n]), "v"(At##8[m]), "v"(sc1)); } } else _Pragma("unroll") for (int m = 0; m < 4; ++m) _Pragma("unroll") for (int n = 0; n < 2; ++n) _Pragma("unroll") for (int k = 0; k < 2; ++k) \
        acc[ai][bj][m][n] = __builtin_amdgcn_mfma_f32_16x16x32_bf16(Bt[n][k], At[m][k], acc[ai][bj][m][n], 0, 0, 0); __builtin_amdgcn_s_setprio(0); } while (0)
#define PG8_WAIT_V(n) asm volatile("s_waitcnt vmcnt(" #n ")" ::: "memory")
#define PG8_WAIT_L(n) asm volatile("s_waitcnt lgkmcnt(" #n ")" ::: "memory")
#define PG8_BAR __builtin_amdgcn_s_barrier()
#define PG8_SCHED __builtin_amdgcn_sched_barrier(0)
    Unit cur, nxt; int ui = 0;
    if (!S.next(0, cur)) return;
    if constexpr (SPLIT) nt = g.ksplit;
    f32x4 acc[2][2][4][2];
#pragma unroll
    for (int a = 0; a < 2; ++a)
#pragma unroll
        for (int b = 0; b < 2; ++b)
#pragma unroll
            for (int m = 0; m < 4; ++m)
#pragma unroll
                for (int n = 0; n < 2; ++n) acc[a][b][m][n] = (f32x4){0.f, 0.f, 0.f, 0.f};
    bf16x8 At[4][2], B0[2][2], B1[2][2];
    v8i_t At8[4], B08[2], B18[2];
    int sc1 = 0x7f7f7f7f; asm volatile("" : "+v"(sc1));
    const char* cA = (const char*)g.A + (size_t)cur.pm * tstep; const char* cB = (const char*)g.Bt + (size_t)cur.pn * tstep;
    S.a_ready(cur);
    if constexpr (SP2) {
        PG8_STAGE(PG8_SB(0, 0), cB, voffB, AUXB); PG8_STAGE(PG8_SB(0, 1), cB + hstep, voffB, AUXB); PG8_STAGE(PG8_SA(0, 0), cA, voffA, AUXA); PG8_STAGE(PG8_SA(0, 1), cA + hstep, voffA, AUXA);
        if (wr == 1) PG8_BAR;
        PG8_WAIT_V(2); PG8_BAR;
        PG8_STAGE(PG8_SB(1, 0), cB + kstep, voffB, AUXB); PG8_STAGE(PG8_SA(1, 0), cA + kstep, voffA, AUXA); PG8_STAGE(PG8_SB(1, 1), cB + hstep + kstep, voffB, AUXB);
        PG8_WAIT_V(6); PG8_BAR;
    } else {
        PG8_STAGE(PG8_SB(0, 0), cB, voffB, AUXB); PG8_STAGE(PG8_SA(0, 0), cA, voffA, AUXA); PG8_STAGE(PG8_SB(0, 1), cB + hstep, voffB, AUXB); PG8_STAGE(PG8_SA(0, 1), cA + hstep, voffA, AUXA);
        if (wr == 1) PG8_BAR;
        PG8_WAIT_V(4); PG8_BAR;
        PG8_STAGE(PG8_SB(1, 0), cB + kstep, voffB, AUXB); PG8_STAGE(PG8_SA(1, 0), cA + kstep, voffA, AUXA); PG8_STAGE(PG8_SB(1, 1), cB + hstep + kstep, voffB, AUXB);
        PG8_WAIT_V(6); PG8_BAR;
    }
    for (;;) {
        const bool has_next = SPLIT ? S.next((ui + 1) >> 1, nxt) : S.next(ui + 1, nxt);
        const size_t nko = (SPLIT && ((ui + 1) & 1)) ? (size_t)g.ksplit * kstep : 0;
        const char* nA = has_next ? (const char*)g.A + (size_t)nxt.pm * tstep + nko : cA; const char* nB = has_next ? (const char*)g.Bt + (size_t)nxt.pn * tstep + nko : cB;
        for (int t = 0; t < nt; t += 2) {
            const bool last = (t == nt - 2);
            const char* a1 = cA + (size_t)(t + 1) * kstep;
            const char* a2 = last ? nA : cA + (size_t)(t + 2) * kstep; const char* b2 = last ? nB : cB + (size_t)(t + 2) * kstep;
            const char* a3 = a2 + kstep; const char* b3 = b2 + kstep;
            if (last && has_next) S.a_ready(nxt);
            if constexpr (SP2) {
            PG8_LDB(B0, 0, 0); PG8_LDB(B1, 0, 1); PG8_SCHED; PG8_LDA(At, 0, 0); PG8_STAGE(PG8_SA(1, 1), a1 + hstep, voffA, AUXA);
            PG8_WAIT_V(8); PG8_WAIT_L(0); PG8_BAR; PG8_MMA(0, 0, At, B0); PG8_MMA(0, 1, At, B1); PG8_BAR; PG8_SCHED;
            PG8_LDA(At, 0, 1); PG8_STAGE(PG8_SB(0, 0), b2, voffB, AUXB); PG8_STAGE(PG8_SB(0, 1), b2 + hstep, voffB, AUXB); PG8_STAGE(PG8_SA(0, 0), a2, voffA, AUXA);
            PG8_WAIT_V(8); PG8_WAIT_L(0); PG8_BAR; PG8_MMA(1, 0, At, B0); PG8_MMA(1, 1, At, B1); PG8_BAR; PG8_SCHED;
            PG8_LDB(B0, 1, 0); PG8_LDB(B1, 1, 1); PG8_SCHED; PG8_LDA(At, 1, 0); PG8_STAGE(PG8_SA(0, 1), a2 + hstep, voffA, AUXA);
            PG8_WAIT_V(8); PG8_WAIT_L(0); PG8_BAR; PG8_MMA(0, 0, At, B0); PG8_MMA(0, 1, At, B1); PG8_BAR; PG8_SCHED;
            PG8_LDA(At, 1, 1); PG8_STAGE(PG8_SB(1, 0), b3, voffB, AUXB); PG8_STAGE(PG8_SB(1, 1), b3 + hstep, voffB, AUXB); PG8_STAGE(PG8_SA(1, 0), a3, voffA, AUXA);
            PG8_WAIT_V(8); PG8_WAIT_L(0); PG8_BAR; PG8_MMA(1, 0, At, B0); PG8_MMA(1, 1, At, B1); PG8_BAR; PG8_SCHED;
            } else {
            PG8_LDB(B0, 0, 0); PG8_SCHED; PG8_LDA(At, 0, 0); PG8_STAGE(PG8_SA(1, 1), a1 + hstep, voffA, AUXA);
            PG8_WAIT_L(8); PG8_BAR; PG8_WAIT_L(0); PG8_MMA(0, 0, At, B0); PG8_BAR; PG8_SCHED;
            PG8_LDB(B1, 0, 1); PG8_STAGE(PG8_SB(0, 0), b2, voffB, AUXB);
            PG8_BAR; PG8_WAIT_L(0); PG8_MMA(0, 1, At, B1); PG8_BAR;
            PG8_LDA(At, 0, 1); PG8_STAGE(PG8_SA(0, 0), a2, voffA, AUXA);
            PG8_BAR; PG8_WAIT_L(0); PG8_MMA(1, 0, At, B0); PG8_BAR; PG8_SCHED;
            PG8_STAGE(PG8_SB(0, 1), b2 + hstep, voffB, AUXB);
            PG8_WAIT_V(6); PG8_BAR; PG8_MMA(1, 1, At, B1); PG8_BAR;
            PG8_LDB(B0, 1, 0); PG8_SCHED; PG8_LDA(At, 1, 0); PG8_STAGE(PG8_SA(0, 1), a2 + hstep, voffA, AUXA);
            PG8_WAIT_L(8); PG8_BAR; PG8_WAIT_L(0); PG8_MMA(0, 0, At, B0); PG8_BAR; PG8_SCHED;
            PG8_LDB(B1, 1, 1); PG8_STAGE(PG8_SB(1, 0), b3, voffB, AUXB);
            PG8_BAR; PG8_WAIT_L(0); PG8_MMA(0, 1, At, B1); PG8_BAR;
            PG8_LDA(At, 1, 1); PG8_STAGE(PG8_SA(1, 0), a3, voffA, AUXA);
            PG8_BAR; PG8_WAIT_L(0); PG8_MMA(1, 0, At, B0); PG8_BAR; PG8_SCHED;
            PG8_STAGE(PG8_SB(1, 1), b3 + hstep, voffB, AUXB);
            PG8_WAIT_V(6); PG8_BAR; PG8_MMA(1, 1, At, B1); PG8_BAR;
            }
        }
        if constexpr (FP8) asm volatile("s_nop 15\n\ts_nop 15" ::: "memory");
        if constexpr (ALIGN_EPI) { if (wr == 0) PG8_BAR; }
        if constexpr (SPLIT) { if ((ui & 1) == 0) E.mid(acc, cur, wr, wc, fr, fq); else E(acc, cur, wr, wc, fr, fq); }
        else if constexpr (!Epi::AFTER_DRAIN) { E(acc, cur, wr, wc, fr, fq); if (MK_DUP_EPI) { asm volatile("" ::: "memory"); E(acc, cur, wr, wc, fr, fq); } S.done(cur); }
        if (!has_next) break;
        if (!SPLIT || (ui & 1)) {
#pragma unroll
        for (int a = 0; a < 2; ++a)
#pragma unroll
            for (int b = 0; b < 2; ++b)
#pragma unroll
                for (int m = 0; m < 4; ++m)
#pragma unroll
                    for (int n = 0; n < 2; ++n) acc[a][b][m][n] = (f32x4){0.f, 0.f, 0.f, 0.f};
        }
        cur = nxt; cA = nA; cB = nB; ++ui;
        if constexpr (SPLIT) nt = (ui & 1) ? (K / BK - g.ksplit) : g.ksplit;
        if constexpr (ALIGN_EPI) { if (wr == 1) PG8_BAR; }
    }
    PG8_WAIT_V(0);
    if constexpr (!ALIGN_EPI) { if (wr == 0) PG8_BAR; }
    PG8_BAR;
    if constexpr (Epi::AFTER_DRAIN) { E.fused(acc, cur, wr, wc, fr, fq, lds, wid, lane); S.done(cur); }
#undef PG8_SA
#undef PG8_SB
#undef PG8_STAGE
#undef PG8_LDA
#undef PG8_LDB
#undef PG8_MMA
#undef PG8_WAIT_V
#undef PG8_WAIT_L
#undef PG8_BAR
#undef PG8_SCHED
}
}

constexpr int NWAVES = 8;
constexpr int BATCH = 2, SEQ = 8192, D = 4096, DEPTH = 2;
constexpr int M = BATCH * SEQ;
constexpr int HEADS = 8, DK = 128, DV = 256, MW = 2048, QKW = 1024;
constexpr int S5W = 1024, S5G = 64, S5N = 16, S5P = 64;
constexpr int DFF = 16384;
constexpr int HZW = 3072;
constexpr int PW = 15376, NP = 15360;
constexpr float EPS = 1e-6f;
constexpr int NPH = 12;

constexpr size_t MiB = 1u << 20;
constexpr size_t WS_CTL = 0, CTL_ZERO_BYTES = 1 * MiB;
constexpr size_t WS_GATES = 1 * MiB;
constexpr size_t WS_RS = 2 * MiB;
constexpr size_t WS_WIN = 4 * MiB, WS_WPA = 125 * MiB  , WS_WGLU = 149 * MiB, WS_WOUT = 151 * MiB, WS_WFF1 = 183 * MiB, WS_WFF2 = 311 * MiB;
constexpr size_t WS_W8 = WS_WIN + 56 * MiB;
constexpr float A8_SCALE = 16.0f, W8_SCALE = 256.0f;
constexpr size_t WS_A8 = 1520 * MiB, WS_END3 = 1584 * MiB;
constexpr size_t WS_XN = 439 * MiB;
constexpr size_t WS_BIG = 567 * MiB;
constexpr size_t WS_SGA = WS_BIG, WS_SGB = WS_BIG + 128 * MiB, WS_QK = WS_BIG + 256 * MiB, WS_V = WS_BIG + 320 * MiB, WS_SO = WS_BIG + 384 * MiB, WS_U = WS_BIG + 448 * MiB;
constexpr size_t WS_SG8A = WS_BIG + 128 * MiB, WS_SG8B = WS_BIG + 192 * MiB;
constexpr size_t WS_H1 = WS_BIG;
constexpr size_t WS_Y32 = 1079 * MiB;
constexpr size_t WS_HG = 1335 * MiB  , WS_Z = 1431 * MiB, WS_ST = 1463 * MiB, WS_END = 1503 * MiB;
constexpr int CW_BAR = 4096;

constexpr int RING_BYTES = 131072;
constexpr int LDSCTL_OFF = 155648, MISC_OFF = LDSCTL_OFF + 320;
constexpr int LDS_BYTES = 163840;

#define LAS __attribute__((address_space(3)))
typedef unsigned short bf16;
typedef unsigned v4u __attribute__((ext_vector_type(4)));
typedef unsigned v2u __attribute__((ext_vector_type(2)));
typedef float f32x4 __attribute__((ext_vector_type(4)));
typedef short bf16x8 __attribute__((ext_vector_type(8)));
#define LDS_WAIT() asm volatile("s_waitcnt lgkmcnt(0)" ::: "memory")
__device__ __forceinline__ float bf2f(unsigned short b) { return __uint_as_float(((unsigned)b) << 16); }
__device__ __forceinline__ unsigned pk2(float lo, float hi) { return pg8::cvt_pk_bf16(lo, hi); }
__device__ __forceinline__ float sigm(float x) { return __builtin_amdgcn_rcpf(1.0f + __builtin_amdgcn_exp2f(-1.44269504f * x)); }
__device__ __forceinline__ float wave_sum(float v) {
#pragma unroll
    for (int o = 1; o < 64; o <<= 1) v += __shfl_xor(v, o);
    return v;
}

#define XB_TMO      128
#define XB_XCNT(j)  (256  + 64 * (j))
#define XB_XSUB(j)  (1280 + 64 * (j))
#define XB_XGEN(j)  (2304 + 64 * (j))
#define XB_TOP      3328
#define XB_TOPGEN   3392
#define XCD_BAR_WORDS 3456
#define XB_SPIN_CAP (1u << 18)

__device__ __forceinline__ unsigned xb_ld(unsigned* p)              { return __hip_atomic_load(p, __ATOMIC_RELAXED, __HIP_MEMORY_SCOPE_AGENT); }
__device__ __forceinline__ unsigned xb_add(unsigned* p, unsigned v) { return __hip_atomic_fetch_add(p, v, __ATOMIC_RELAXED, __HIP_MEMORY_SCOPE_AGENT); }
__device__ __forceinline__ unsigned xb_xcc_id() { return (unsigned)__builtin_amdgcn_s_getreg((3 << 11) | 20) & 0xFu; }
#define XB_SPIN(cond, bar) do { unsigned _sp = 0; while (cond) { __builtin_amdgcn_s_sleep(1); \
    if ((++_sp & 255u) == 0u) { if (xb_ld(&(bar)[XB_TMO])) break; if (_sp > XB_SPIN_CAP) { atomicAdd(&(bar)[XB_TMO], 1u); break; } } } } while (0)

struct XcdBarrier {
    unsigned* bar; unsigned x;
    volatile LAS unsigned* st;
};

__device__ __forceinline__ XcdBarrier xcd_barrier_post(unsigned* bar, volatile LAS unsigned* st) {
    XcdBarrier b; b.bar = bar; b.x = xb_xcc_id(); b.st = st;
    if (threadIdx.x == 0) (void)xb_add(&bar[XB_XCNT(b.x)], 1u);
    return b;
}
__device__ __forceinline__ void xcd_barrier_complete(unsigned* bar, unsigned x, unsigned& nloc, unsigned& nx) {
    const unsigned G = gridDim.x * gridDim.y * gridDim.z;
    unsigned sum, cnt, mine, sp = 0u;
    for (;;) {
        sum = 0u; cnt = 0u; mine = 0u;
#pragma unroll
        for (unsigned j = 0; j < 16; ++j) { const unsigned c = xb_ld(&bar[XB_XCNT(j)]); sum += c; cnt += (c > 0u) ? 1u : 0u; mine = (j == x) ? c : mine; }
        if (sum == G) break;
        __builtin_amdgcn_s_sleep(1);
        if ((++sp & 255u) == 0u) { if (xb_ld(&bar[XB_TMO])) break; if (sp > XB_SPIN_CAP) { atomicAdd(&bar[XB_TMO], 1u); break; } }
    }
    nloc = mine > 0u ? mine : 1u; nx = cnt > 0u ? cnt : 1u;
}

__device__ __forceinline__ void xcd_barrier(const XcdBarrier& b) {
    asm volatile("s_waitcnt vmcnt(0)" ::: "memory");
    __syncthreads();
    if (threadIdx.x == 0) {
        unsigned* bar = b.bar;
        __builtin_amdgcn_s_waitcnt(0);
        unsigned nloc = b.st[0], nx = b.st[1];
        if (nloc == 0u) { xcd_barrier_complete(bar, b.x, nloc, nx); b.st[0] = nloc; b.st[1] = nx; }
        const unsigned old = xb_add(&bar[XB_XSUB(b.x)], 1u);
        const unsigned gen = old / nloc;
        if (old + 1u == (gen + 1u) * nloc) {
            __builtin_amdgcn_fence(__ATOMIC_RELEASE, "agent");
            asm volatile("s_waitcnt vmcnt(0)" ::: "memory");
            const unsigned og = xb_add(&bar[XB_TOP], 1u);
            const unsigned tg = og / nx;
            if (og + 1u == (tg + 1u) * nx) xb_add(&bar[XB_TOPGEN], 1u);
            else XB_SPIN(xb_ld(&bar[XB_TOPGEN]) == tg, bar);
            __builtin_amdgcn_fence(__ATOMIC_ACQUIRE, "agent");
            xb_add(&bar[XB_XGEN(b.x)], 1u);
            asm volatile("s_waitcnt vmcnt(0)" ::: "memory");
        } else {
            XB_SPIN(xb_ld(&bar[XB_XGEN(b.x)]) == gen, bar);
            __builtin_amdgcn_fence(__ATOMIC_ACQUIRE, "agent");
            asm volatile("s_waitcnt vmcnt(0)" ::: "memory");
        }
    }
    __syncthreads();
}

struct Params { const float* in[25]; float* out; unsigned char* ws; int l_lo, l_hi, ph_lo, ph_hi, li, pad; };

__device__ __forceinline__ void transpose_item(const float* W, int K, int N, int nsrc0, bf16* WT, int rdst0, LAS float* scr, int kb, int nb, int lane, const float* gk = nullptr, int pitch = 0, int koff = 0) {
    if (!pitch) pitch = K;
    const int k0 = 64 * kb, n0 = 32 * nb;
    { const int r8 = lane >> 3, c4 = (lane & 7) * 4; f32x4 v[8];
#pragma unroll
      for (int i = 0; i < 8; ++i) v[i] = *(const f32x4*)(W + (size_t)(k0 + 8 * i + r8) * N + nsrc0 + n0 + c4);
#pragma unroll
      for (int i = 0; i < 8; ++i) { LAS float* d = scr + (8 * i + r8) * 33 + c4; d[0] = v[i].x; d[1] = v[i].y; d[2] = v[i].z; d[3] = v[i].w; } }
    LDS_WAIT(); asm volatile("" ::: "memory");
    const int c = lane & 7;
    f32x4 ga = (f32x4){1.f, 1.f, 1.f, 1.f}, gb = ga; if (gk) { ga = *(const f32x4*)(gk + k0 + 8 * c); gb = *(const f32x4*)(gk + k0 + 8 * c + 4); }
#pragma unroll
    for (int j = 0; j < 4; ++j) { const int n = (lane >> 3) + 8 * j; const LAS float* s = scr + (8 * c) * 33 + n;
        v4u o; o.x = pk2(s[0 * 33] * ga.x, s[1 * 33] * ga.y); o.y = pk2(s[2 * 33] * ga.z, s[3 * 33] * ga.w); o.z = pk2(s[4 * 33] * gb.x, s[5 * 33] * gb.y); o.w = pk2(s[6 * 33] * gb.z, s[7 * 33] * gb.w);
        *(v4u*)(WT + (size_t)(rdst0 + n0 + n) * pitch + koff + k0 + 8 * c) = o; }
    LDS_WAIT(); asm volatile("" ::: "memory");
}

__device__ __forceinline__ unsigned pk4_fp8(float a, float b, float c, float d) { unsigned w = __builtin_amdgcn_cvt_pk_fp8_f32(a, b, 0u, false); return __builtin_amdgcn_cvt_pk_fp8_f32(c, d, w, true); }
__device__ __forceinline__ void transpose_item8(const float* W, int K, int N, int nsrc0, unsigned char* W8, int rdst0, LAS float* scr, int kb, int nb, int lane, const float* gk, float scale) {
    const int k0 = 64 * kb, n0 = 32 * nb;
    { const int r8 = lane >> 3, c4 = (lane & 7) * 4; f32x4 v[8];
#pragma unroll
      for (int i = 0; i < 8; ++i) v[i] = *(const f32x4*)(W + (size_t)(k0 + 8 * i + r8) * N + nsrc0 + n0 + c4);
#pragma unroll
      for (int i = 0; i < 8; ++i) { LAS float* d = scr + (8 * i + r8) * 33 + c4; d[0] = v[i].x; d[1] = v[i].y; d[2] = v[i].z; d[3] = v[i].w; } }
    LDS_WAIT(); asm volatile("" ::: "memory");
    const int c = lane & 7;
    const f32x4 ga = *(const f32x4*)(gk + k0 + 8 * c) * scale, gb = *(const f32x4*)(gk + k0 + 8 * c + 4) * scale;
#pragma unroll
    for (int j = 0; j < 4; ++j) { const int n = (lane >> 3) + 8 * j; const LAS float* s = scr + (8 * c) * 33 + n;
        v2u o; o.x = pk4_fp8(s[0 * 33] * ga.x, s[1 * 33] * ga.y, s[2 * 33] * ga.z, s[3 * 33] * ga.w); o.y = pk4_fp8(s[4 * 33] * gb.x, s[5 * 33] * gb.y, s[6 * 33] * gb.z, s[7 * 33] * gb.w);
        *(v2u*)(W8 + (size_t)(rdst0 + n0 + n) * K + k0 + 8 * c) = o; }
    LDS_WAIT(); asm volatile("" ::: "memory");
}

__device__ __forceinline__ void unpack8f(const v4u w, f32x4& a, f32x4& b) {
    a = (f32x4){__uint_as_float(w.x << 16), __uint_as_float(w.x & 0xffff0000u), __uint_as_float(w.y << 16), __uint_as_float(w.y & 0xffff0000u)};
    b = (f32x4){__uint_as_float(w.z << 16), __uint_as_float(w.z & 0xffff0000u), __uint_as_float(w.w << 16), __uint_as_float(w.w & 0xffff0000u)};
}
typedef __bf16 mk_bf16x2 __attribute__((ext_vector_type(2)));
__device__ __forceinline__ float dot2bf(unsigned a, unsigned b, float c) { return __builtin_amdgcn_fdot2_f32_bf16(__builtin_bit_cast(mk_bf16x2, a), __builtin_bit_cast(mk_bf16x2, b), c, false); }
__device__ __forceinline__ void stage_gate_w(const float* w_in_l, const float* g_mix_l, LAS unsigned char* lds, int tid) {
    for (int k = tid; k < D; k += NWAVES * 64) { const f32x4* src = (const f32x4*)(w_in_l + (size_t)k * PW + 6144); const float gk = g_mix_l[k];
        const f32x4 a = src[0] * gk, b = src[1] * gk, c = src[2] * gk, d = src[3] * gk; const float v[16] = {a.x, a.y, a.z, a.w, b.x, b.y, b.z, b.w, c.x, c.y, c.z, c.w, d.x, d.y, d.z, d.w};
#pragma unroll
        for (int j = 0; j < 16; ++j) *(LAS bf16*)(lds + j * (D * 2) + k * 2) = (bf16)(pk2(v[j], 0.f) & 0xffffu); }
}
__device__ __forceinline__ void resid_rows(const float* xf, bf16* XB, const bf16* y, const float* gpost, bool xb_out, float* out32, float* RN, int gw, int ngw, int lane, bf16* XBo = nullptr, float* RNo = nullptr, unsigned char* A8 = nullptr, const LAS unsigned char* wg = nullptr, float* GATES = nullptr) {
    if (!XBo) XBo = XB; if (!RNo) RNo = RN;
    for (int m = gw; m < M; m += ngw) {
        f32x4 xv[16];
        if (xf) { const f32x4* xr = (const f32x4*)(xf + (size_t)m * D) + 2 * lane;
#pragma unroll
            for (int j = 0; j < 8; ++j) { xv[2 * j] = xr[128 * j]; xv[2 * j + 1] = xr[128 * j + 1]; } }
        else { const v4u* xr = (const v4u*)(XB + (size_t)m * D) + lane; const float rn = RN[m];
#pragma unroll
            for (int j = 0; j < 8; ++j) { unpack8f(xr[64 * j], xv[2 * j], xv[2 * j + 1]); xv[2 * j] = xv[2 * j] * rn; xv[2 * j + 1] = xv[2 * j + 1] * rn; } }
        if (y) {
            f32x4 yv[16]; float ss = 0.f;
            const v4u* yr = (const v4u*)(y + (size_t)m * D) + lane;
#pragma unroll
            for (int j = 0; j < 8; ++j) unpack8f(yr[64 * j], yv[2 * j], yv[2 * j + 1]);
#pragma unroll
            for (int j = 0; j < 16; ++j) ss += (yv[j].x * yv[j].x + yv[j].y * yv[j].y) + (yv[j].z * yv[j].z + yv[j].w * yv[j].w);
            const float rstd = 1.0f / sqrtf(wave_sum(ss) * (1.0f / D) + EPS);
#pragma unroll
            for (int j = 0; j < 8; ++j) {
#pragma unroll
                for (int k = 0; k < 2; ++k) { const f32x4 g = ((const f32x4*)gpost)[2 * lane + 128 * j + k]; xv[2 * j + k] = xv[2 * j + k] + yv[2 * j + k] * rstd * g; } }
        }
        if (out32) { f32x4* xo = (f32x4*)(out32 + (size_t)m * D) + 2 * lane;
#pragma unroll
            for (int j = 0; j < 8; ++j) { xo[128 * j] = xv[2 * j]; xo[128 * j + 1] = xv[2 * j + 1]; } }
        if (xb_out) {
            float s2 = 0.f;
#pragma unroll
            for (int j = 0; j < 16; ++j) s2 += (xv[j].x * xv[j].x + xv[j].y * xv[j].y) + (xv[j].z * xv[j].z + xv[j].w * xv[j].w);
            const float ms = wave_sum(s2) * (1.0f / D) + EPS; const float rs2 = 1.0f / sqrtf(ms);
            v4u* o16 = (v4u*)(XBo + (size_t)m * D) + lane;
            v4u wq[8];
#pragma unroll
            for (int j = 0; j < 8; ++j) { const f32x4 a = xv[2 * j] * rs2, b = xv[2 * j + 1] * rs2; v4u w; w.x = pk2(a.x, a.y); w.y = pk2(a.z, a.w); w.z = pk2(b.x, b.y); w.w = pk2(b.z, b.w); o16[64 * j] = w; wq[j] = w; }
            if (GATES) {
                float ga[16];
#pragma unroll
                for (int g = 0; g < 16; ++g) ga[g] = 0.f;
#pragma unroll
                for (int j = 0; j < 8; ++j)
#pragma unroll
                    for (int g = 0; g < 16; ++g) { const v4u wv = *(const LAS v4u*)(wg + g * (D * 2) + j * 1024 + lane * 16);
                        ga[g] = dot2bf(wq[j].x, wv.x, ga[g]); ga[g] = dot2bf(wq[j].y, wv.y, ga[g]); ga[g] = dot2bf(wq[j].z, wv.z, ga[g]); ga[g] = dot2bf(wq[j].w, wv.w, ga[g]); }
#pragma unroll
                for (int i = 0; i < 8; ++i) { const bool up = (lane & 32) != 0; const float snd = up ? ga[i] : ga[i + 8], kp = up ? ga[i + 8] : ga[i]; ga[i] = kp + __shfl_xor(snd, 32); }
#pragma unroll
                for (int i = 0; i < 4; ++i) { const bool up = (lane & 16) != 0; const float snd = up ? ga[i] : ga[i + 4], kp = up ? ga[i + 4] : ga[i]; ga[i] = kp + __shfl_xor(snd, 16); }
#pragma unroll
                for (int i = 0; i < 2; ++i) { const bool up = (lane & 8) != 0; const float snd = up ? ga[i] : ga[i + 2], kp = up ? ga[i + 2] : ga[i]; ga[i] = kp + __shfl_xor(snd, 8); }
                { const bool up = (lane & 4) != 0; const float snd = up ? ga[0] : ga[1], kp = up ? ga[1] : ga[0]; ga[0] = kp + __shfl_xor(snd, 4); }
                ga[0] += __shfl_xor(ga[0], 2); ga[0] += __shfl_xor(ga[0], 1);
                if ((lane & 3) == 0) GATES[(size_t)m * 16 + (lane >> 2)] = ga[0];
            }
            if (A8) { v2u* o8 = (v2u*)(A8 + (size_t)m * D) + lane; const float s8 = rs2 * A8_SCALE;
#pragma unroll
                for (int j = 0; j < 8; ++j) { const f32x4 a = xv[2 * j] * s8, b = xv[2 * j + 1] * s8; v2u w; w.x = pk4_fp8(a.x, a.y, a.z, a.w); w.y = pk4_fp8(b.x, b.y, b.z, b.w); o8[64 * j] = w; } }
            if (lane == 0) RNo[m] = sqrtf(ms); }
    }
}

__device__ __forceinline__ void gates_phase(const bf16* XN, const bf16* Wg, float* GATES, LAS unsigned char* lds, int gw, int ngw, int wave, int lane) {
    LAS f32x4* red = (LAS f32x4*)lds;
    for (int u = gw; u < M / 8; u += ngw) {
        const int row0 = (u >> 1) * 16, kh = u & 1; f32x4 acc0 = (f32x4){0.f, 0.f, 0.f, 0.f}, acc1 = acc0;
        const bf16* ap = XN + (size_t)(row0 + (lane & 15)) * D + kh * (D / 2) + (lane >> 4) * 8;
        const bf16* bp = Wg + (size_t)(lane & 15) * D + kh * (D / 2) + (lane >> 4) * 8;
#pragma unroll 1
        for (int kb = 0; kb < 4; ++kb) {
            bf16x8 a[16], b[16];
#pragma unroll
            for (int kk = 0; kk < 16; ++kk) { a[kk] = *(const bf16x8*)(ap + (kb * 16 + kk) * 32); b[kk] = *(const bf16x8*)(bp + (kb * 16 + kk) * 32); }
#pragma unroll
            for (int kk = 0; kk < 16; kk += 2) { acc0 = __builtin_amdgcn_mfma_f32_16x16x32_bf16(a[kk], b[kk], acc0, 0, 0, 0); acc1 = __builtin_amdgcn_mfma_f32_16x16x32_bf16(a[kk + 1], b[kk + 1], acc1, 0, 0, 0); }
        }
        f32x4 s = acc0 + acc1;
        if (kh) red[(wave >> 1) * 64 + lane] = s;
        __syncthreads();
        if (!kh) { s += red[(wave >> 1) * 64 + lane];
#pragma unroll
            for (int r = 0; r < 4; ++r) GATES[(size_t)(row0 + 4 * (lane >> 4) + r) * 16 + (lane & 15)] = s[r]; }
        __syncthreads();
    }
}

__device__ __forceinline__ float gelu_tanh(float x) { return x * sigm(1.5957691216057308f * (x + 0.044715f * x * x * x)); }

struct TItem { const float* W; int N, nsrc0, k0, n0; unsigned char* dst; int pitchB, esz; const float* gk; float scale; };
__device__ __forceinline__ void titem_load(const TItem& I, f32x4 (&v)[8], int lane) {
    const int r8 = lane >> 3, c4 = (lane & 7) * 4;
#pragma unroll
    for (int i = 0; i < 8; ++i) v[i] = *(const f32x4*)(I.W + (size_t)(I.k0 + 8 * i + r8) * I.N + I.nsrc0 + I.n0 + c4);
}
__device__ __forceinline__ void titem_to_lds(const f32x4 (&v)[8], LAS float* scr, int lane) {
    const int r8 = lane >> 3, c4 = (lane & 7) * 4;
#pragma unroll
    for (int i = 0; i < 8; ++i) { LAS float* d = scr + (8 * i + r8) * 33 + c4; d[0] = v[i].x; d[1] = v[i].y; d[2] = v[i].z; d[3] = v[i].w; }
}
__device__ __forceinline__ void titem_store(const TItem& I, LAS float* scr, int lane) {
    const int c = lane & 7;
    f32x4 ga = (f32x4){I.scale, I.scale, I.scale, I.scale}, gb = ga; if (I.gk) { ga = *(const f32x4*)(I.gk + I.k0 + 8 * c) * I.scale; gb = *(const f32x4*)(I.gk + I.k0 + 8 * c + 4) * I.scale; }
#pragma unroll
    for (int j = 0; j < 4; ++j) { const int n = (lane >> 3) + 8 * j; const LAS float* s = scr + (8 * c) * 33 + n;
        const float e0 = s[0 * 33] * ga.x, e1 = s[1 * 33] * ga.y, e2 = s[2 * 33] * ga.z, e3 = s[3 * 33] * ga.w, e4 = s[4 * 33] * gb.x, e5 = s[5 * 33] * gb.y, e6 = s[6 * 33] * gb.z, e7 = s[7 * 33] * gb.w;
        unsigned char* d = I.dst + (size_t)(I.n0 + n) * I.pitchB + (size_t)(I.k0 + 8 * c) * I.esz;
        if (I.esz == 2) { v4u o; o.x = pk2(e0, e1); o.y = pk2(e2, e3); o.z = pk2(e4, e5); o.w = pk2(e6, e7); *(v4u*)d = o; }
        else { v2u o; o.x = pk4_fp8(e0, e1, e2, e3); o.y = pk4_fp8(e4, e5, e6, e7); *(v2u*)d = o; } }
}
__device__ __forceinline__ void prep_phase(const Params& p, int l, LAS unsigned char* lds, int bid, int G, int wave, int lane) {
    LAS float* scr = (LAS float*)(lds + wave * 16384);
    const int gw = bid * NWAVES + wave, NGW = G * NWAVES;
    const float* g_mix = p.in[1] + (size_t)l * D; const float* g_mlp = p.in[3] + (size_t)l * D;
    const float* w_in = p.in[5] + (size_t)l * D * PW; const float* p_a = p.in[10] + (size_t)l * MW * D; const float* w_glu = p.in[19] + (size_t)l * S5W * S5W;
    const float* p_b = p.in[21] + (size_t)l * S5W * D; const float* w_out = p.in[22] + (size_t)l * D * D; const float* w_ff1 = p.in[23] + (size_t)l * D * DFF; const float* w_ff2 = p.in[24] + (size_t)l * DFF * D;
    unsigned char* ws = p.ws; bf16* WIN = (bf16*)(ws + WS_WIN);
    constexpr int I_IN1 = (D / 64) * (6144 / 32), I_IN2 = (D / 64) * (1024 / 32), I_IN8 = (D / 64) * (8192 / 32), I_PA = (MW / 64) * (D / 32), I_GLU = (S5W / 64) * (S5W / 32), I_PB = (S5W / 64) * (D / 32),
                  I_OUT = (D / 64) * (D / 32), I_FF1 = (D / 64) * (DFF / 32), I_FF2 = (DFF / 64) * (D / 32);
    constexpr int NITEMS = I_IN1 + I_IN2 + I_IN8 + I_PA + I_GLU + I_PB + I_OUT + I_FF1 + I_FF2;
#define TI(W_, N_, nsrc_, nblk_, dst_, pitchB_, esz_, koffB_, gk_, sc_) do { I.W = (W_); I.N = (N_); I.nsrc0 = (nsrc_); I.k0 = 64 * (r / (nblk_)); I.n0 = 32 * (r % (nblk_)); I.dst = (dst_) + (koffB_); I.pitchB = (pitchB_); I.esz = (esz_); I.gk = (gk_); I.scale = (sc_); } while (0)
    auto decode = [&](int it, TItem& I) { int r = NITEMS - 1 - it;
        if (r < I_IN1) { TI(w_in, PW, 0, 192, ws + WS_WIN, D * 2, 2, 0, g_mix, 1.f); return; } r -= I_IN1;
        if (r < I_IN2) { TI(w_in, PW, 6160, 32, ws + WS_WIN + (size_t)6144 * D * 2, D * 2, 2, 0, g_mix, 1.f); return; } r -= I_IN2;
        if (r < I_IN8) { TI(w_in, PW, 7184, 256, ws + WS_W8, D, 1, 0, g_mix, W8_SCALE); return; } r -= I_IN8;
        if (r < I_PA) { TI(p_a, D, 0, 128, ws + WS_WPA, HZW * 2, 2, 0, nullptr, 1.f); return; } r -= I_PA;
        if (r < I_GLU) { TI(w_glu, S5W, 0, 32, ws + WS_WGLU, S5W * 2, 2, 0, nullptr, 1.f); return; } r -= I_GLU;
        if (r < I_PB) { TI(p_b, D, 0, 128, ws + WS_WPA, HZW * 2, 2, MW * 2, nullptr, 1.f); return; } r -= I_PB;
        if (r < I_OUT) { TI(w_out, D, 0, 128, ws + WS_WOUT, D * 2, 2, 0, nullptr, 1.f); return; } r -= I_OUT;
        if (r < I_FF1) { TI(w_ff1, DFF, 0, 512, ws + WS_WFF1, D * 2, 2, 0, g_mlp, 1.f); return; } r -= I_FF1;
        TI(w_ff2, D, 0, 128, ws + WS_WFF2, DFF * 2, 2, 0, nullptr, 1.f); };
    if (gw < NITEMS) {
        TItem cur, nxt; f32x4 v[8];
        decode(gw, cur); titem_load(cur, v, lane);
        for (int it = gw; it < NITEMS; it += NGW) {
            titem_to_lds(v, scr, lane);
            const bool more = it + NGW < NITEMS;
            if (more) { decode(it + NGW, nxt); titem_load(nxt, v, lane); }
            LDS_WAIT(); asm volatile("" ::: "memory");
            titem_store(cur, scr, lane);
            LDS_WAIT(); asm volatile("" ::: "memory");
            if (more) cur = nxt;
        }
    }
#undef TI
    for (int e = bid * 512 + (int)threadIdx.x; e < 16 * D; e += G * 512) { const int j = e & 15, k = e >> 4; WIN[(size_t)(NP + j) * D + k] = (bf16)(pk2(w_in[(size_t)k * PW + 6144 + j] * g_mix[k], 0.f) & 0xffffu); }
    if (l == 0) { __syncthreads();
        stage_gate_w(w_in, g_mix, lds, wave * 64 + lane); __syncthreads();
        resid_rows(p.in[0], (bf16*)(p.ws + WS_XN), nullptr, nullptr, true, nullptr, (float*)(p.ws + WS_RS), gw, NGW, lane, nullptr, nullptr, p.ws + WS_A8, lds, (float*)(p.ws + WS_GATES)); }
}

typedef short s16x4 __attribute__((ext_vector_type(4)));
#define MFMA16(a, b, c) __builtin_amdgcn_mfma_f32_16x16x32_bf16(a, b, c, 0, 0, 0)
constexpr int ML_QI = 0, ML_KI = 17408, ML_VI = 34816, ML_PI = 70656, ML_EB = 79872, ML_EKW = 81920, ML_EG = 83968, ML_LG = 84000, ML_HT = 84480, ML_GN = 151040;
constexpr int QSTR = 272, VSTR = 560, PSTR = 144, HSTR = 260;
constexpr size_t ST_UNIT = 139264;
constexpr size_t WS_STG = WS_ST + 256 * ST_UNIT;
static_assert(WS_STG + 4096 <= WS_END, "ws map");
constexpr size_t WS_QKC = WS_Y32;
constexpr size_t WS_ST2 = WS_Y32 + 64 * MiB;

__device__ __forceinline__ bf16x8 tr_frag(const LAS unsigned char* p0, const LAS unsigned char* p1) {
    const s16x4 a = __builtin_amdgcn_ds_read_tr16_b64_v4i16((LAS s16x4*)p0), b = __builtin_amdgcn_ds_read_tr16_b64_v4i16((LAS s16x4*)p1);
    return __builtin_shufflevector(a, b, 0, 1, 2, 3, 4, 5, 6, 7);
}
__device__ __forceinline__ bf16x8 pack8(const f32x4 a, const f32x4 b) { v4u w; w.x = pk2(a.x, a.y); w.y = pk2(a.z, a.w); w.z = pk2(b.x, b.y); w.w = pk2(b.z, b.w); return __builtin_bit_cast(bf16x8, w); }

template <bool FULL>
__device__ __forceinline__ void mlstm_unit(const Params& p, int l, int unit, LAS unsigned char* lds, int tid_, int lane_, int wave) {
    int tid = tid_; asm volatile("" : "+v"(tid));
    const int lane = tid & 63; (void)lane_;
    const int b = unit >> 7, h = (unit >> 4) & 7, seg = unit & 15;
    const bf16* QK = (const bf16*)(p.ws + WS_QK); const bf16* V = (const bf16*)(p.ws + WS_V); const float* GATES = (const float*)(p.ws + WS_GATES);
    bf16* QKC = (bf16*)(p.ws + WS_QKC); const bf16* SO = (const bf16*)(p.ws + WS_SO); bf16* HG = (bf16*)(p.ws + WS_HG);
    float* STC = (float*)(p.ws + WS_ST + (size_t)unit * ST_UNIT); float* STG = (float*)(p.ws + WS_STG);
    LAS float* EB = (LAS float*)(lds + ML_EB); LAS float* EKW = (LAS float*)(lds + ML_EKW); LAS float* EG = (LAS float*)(lds + ML_EG); LAS float* LG = (LAS float*)(lds + ML_LG);
    LAS float* HT = (LAS float*)(lds + ML_HT);
    const int g4 = lane >> 4, q4 = (lane & 15) >> 2, p4 = lane & 3, c16 = lane & 15;
    const size_t rowb = (size_t)b * SEQ; const int t0 = seg * 512;
    { const size_t row = rowb + t0 + wave * 64 + lane;
      const float ip = GATES[row * 16 + h] + p.in[7][l * 8 + h], fp = GATES[row * 16 + 8 + h] + p.in[8][l * 8 + h];
      float bsum = -log1pf(__expf(-fp));
#pragma unroll
      for (int o = 1; o < 64; o <<= 1) { const float t = __shfl_up(bsum, o); if (lane >= o) bsum += t; }
      EB[wave * 64 + lane] = __expf(bsum); EKW[wave * 64 + lane] = __expf(ip - bsum);
      if (lane == 63) { EG[wave] = __expf(bsum); LG[wave] = bsum; } }
    f32x4 Cacc[8][3];
#pragma unroll
    for (int i = 0; i < 8; ++i)
#pragma unroll
        for (int j = 0; j < 3; ++j) Cacc[i][j] = (f32x4){0.f, 0.f, 0.f, 0.f};
    if (FULL && seg > 0) {
        const float* sj = (const float*)(p.ws + WS_ST2 + (size_t)unit * ST_UNIT);
#pragma unroll
        for (int i = 0; i < 8; ++i) {
#pragma unroll
            for (int n = 0; n < 2; ++n) Cacc[i][n] = *(const f32x4*)(sj + ((size_t)(i * 2 + n) * 512 + tid) * 4);
            Cacc[i][2] = *(const f32x4*)(sj + 32768 + ((size_t)i * 64 + lane) * 4);
        }
    }
    const int which = tid >> 8, sb = (tid >> 7) & 1, dch = tid & 127, ch = which * 1024 + h * 128 + dch;
    float cw0 = 0.f, cw1 = 0.f, cw2 = 0.f, cw3 = 0.f;
    if (!FULL) { const float* cw = p.in[6] + (size_t)l * 4 * 2048; cw0 = cw[ch]; cw1 = cw[2048 + ch]; cw2 = cw[4096 + ch]; cw3 = cw[6144 + ch]; }
    const int vrow = tid >> 3, vc8 = (tid & 7) * 8;
    unsigned short rawh[FULL ? 1 : 35]; v4u qkr[FULL ? 4 : 1]; v4u vr[4];
#define ML_LOAD(c_) do { const size_t Rl = rowb + t0 + (c_) * 64; \
        if (!FULL) { const int tq0 = t0 + (c_) * 64 + 32 * sb - 3; _Pragma("unroll") for (int i = 0; i < 35; ++i) rawh[i] = (tq0 + i >= 0) ? QK[(rowb + tq0 + i) * 2048 + ch] : (unsigned short)0; } \
        else { _Pragma("unroll") for (int i = 0; i < 2; ++i) { const int col = i * 64 + vc8; qkr[i] = *(const v4u*)(QKC + (Rl + vrow) * 2048 + h * 128 + col); qkr[2 + i] = *(const v4u*)(QKC + (Rl + vrow) * 2048 + 1024 + h * 128 + col); } } \
        _Pragma("unroll") for (int i = 0; i < 4; ++i) vr[i] = *(const v4u*)(V + (Rl + vrow) * 2048 + h * 256 + i * 64 + vc8); } while (0)
    ML_LOAD(0);
    if (FULL) { if (tid < 256) ((LAS float*)(lds + ML_GN))[tid] = p.in[9][(size_t)l * MW + h * 256 + tid]; }
    if ((tid & 7) == 0) { const v4u z = (v4u){0u, 0u, 0u, 0u}; *(LAS v4u*)(lds + ML_VI + vrow * VSTR + 512) = z; *(LAS v4u*)(lds + ML_VI + vrow * VSTR + 528) = z; }
    __syncthreads();
#pragma unroll 1
    for (int c = 0; c < 8; ++c) {
        const size_t Rc = rowb + t0 + c * 64;
        int tz = tid; asm volatile("" : "+v"(tz));
        const int lane = tz & 63, g4 = lane >> 4, q4 = (lane & 15) >> 2, p4 = lane & 3, c16 = lane & 15, vrow = tz >> 3, vc8 = (tz & 7) * 8, dch = tz & 127, sb = (tz >> 7) & 1;
        if (!FULL) {
#pragma unroll
            for (int s2 = 0; s2 < 32; ++s2) {
                const float a = cw0 * bf2f(rawh[s2]) + cw1 * bf2f(rawh[s2 + 1]) + cw2 * bf2f(rawh[s2 + 2]) + cw3 * bf2f(rawh[s2 + 3]);
                float val = a * sigm(a); if (!which) val *= 0.08838834764831845f;
                const bf16 bv = (bf16)(pk2(val, 0.f) & 0xffffu);
                QKC[(Rc + 32 * sb + s2) * 2048 + ch] = bv;
                if (which) *(LAS bf16*)(lds + ML_KI + (32 * sb + s2) * QSTR + dch * 2) = bv;
            }
        } else {
#pragma unroll
            for (int i = 0; i < 2; ++i) { const int col = i * 64 + vc8;
                *(LAS v4u*)(lds + ML_QI + vrow * QSTR + col * 2) = qkr[i];
                *(LAS v4u*)(lds + ML_KI + vrow * QSTR + col * 2) = qkr[2 + i]; }
        }
        { const float ek = EKW[c * 64 + vrow];
#pragma unroll
          for (int i = 0; i < 4; ++i) { const int col = i * 64 + vc8; const v4u w = vr[i];
              v4u o; o.x = pk2(__uint_as_float(w.x << 16) * ek, __uint_as_float(w.x & 0xffff0000u) * ek); o.y = pk2(__uint_as_float(w.y << 16) * ek, __uint_as_float(w.y & 0xffff0000u) * ek);
              o.z = pk2(__uint_as_float(w.z << 16) * ek, __uint_as_float(w.z & 0xffff0000u) * ek); o.w = pk2(__uint_as_float(w.w << 16) * ek, __uint_as_float(w.w & 0xffff0000u) * ek);
              *(LAS v4u*)(lds + ML_VI + vrow * VSTR + col * 2) = o; }
          if ((tid & 7) == 0) *(LAS bf16*)(lds + ML_VI + vrow * VSTR + 512) = (bf16)(pk2(ek, 0.f) & 0xffffu); }
        __syncthreads();
        if (!FULL) { if (c + 1 < 8) ML_LOAD(c + 1); }
        if (FULL) {
            const int mt = wave >> 1, ntb = 2 * (wave & 1);
            f32x4 sacc[2] = {(f32x4){0.f, 0.f, 0.f, 0.f}, (f32x4){0.f, 0.f, 0.f, 0.f}};
#pragma unroll
            for (int ks = 0; ks < 4; ++ks) { const bf16x8 a = *(const LAS bf16x8*)(lds + ML_QI + (16 * mt + c16) * QSTR + (32 * ks + 8 * g4) * 2);
#pragma unroll
                for (int n2 = 0; n2 < 2; ++n2) { const bf16x8 bb = *(const LAS bf16x8*)(lds + ML_KI + (16 * (ntb + n2) + c16) * QSTR + (32 * ks + 8 * g4) * 2); sacc[n2] = MFMA16(a, bb, sacc[n2]); } }
#pragma unroll
            for (int n2 = 0; n2 < 2; ++n2)
#pragma unroll
                for (int r = 0; r < 4; ++r) { const int t = 16 * mt + 4 * g4 + r, s = 16 * (ntb + n2) + c16;
                    const float val = (s <= t) ? sacc[n2][r] * EB[c * 64 + t] : 0.f;
                    *(LAS bf16*)(lds + ML_PI + t * PSTR + s * 2) = (bf16)(pk2(val, 0.f) & 0xffffu); }
            __syncthreads();
        }
        bf16x8 bV[2][3];
#pragma unroll
        for (int ks = 0; ks < 2; ++ks)
#pragma unroll
            for (int n = 0; n < 3; ++n) { const int col0 = (n < 2) ? (32 * wave + 16 * n) : 256;
                const LAS unsigned char* a0 = lds + ML_VI + (32 * ks + 8 * g4 + q4) * VSTR + (col0 + 4 * p4) * 2;
                bV[ks][n] = tr_frag(a0, a0 + 4 * VSTR); }
        if (FULL) {
            int tzm = tid; asm volatile("" : "+v"(tzm)); const int lane = tzm & 63, g4 = lane >> 4, q4 = (lane & 15) >> 2, p4 = lane & 3, c16 = lane & 15, vrow = tzm >> 3, vc8 = (tzm & 7) * 8; (void)q4; (void)p4; (void)c16; (void)vrow; (void)vc8; (void)g4;
            bf16x8 Cb[4][3];
#pragma unroll
            for (int ks = 0; ks < 4; ++ks)
#pragma unroll
                for (int n = 0; n < 3; ++n) Cb[ks][n] = pack8(Cacc[2 * ks][n], Cacc[2 * ks + 1][n]);
#pragma unroll 2
            for (int m = 0; m < 4; ++m) {
                f32x4 nacc[3] = {(f32x4){0.f, 0.f, 0.f, 0.f}, (f32x4){0.f, 0.f, 0.f, 0.f}, (f32x4){0.f, 0.f, 0.f, 0.f}};
#pragma unroll
                for (int ks = 0; ks < 4; ++ks) {
                    const s16x4 lo = *(const LAS s16x4*)(lds + ML_QI + (16 * m + c16) * QSTR + (32 * ks + 4 * g4) * 2), hi = *(const LAS s16x4*)(lds + ML_QI + (16 * m + c16) * QSTR + (32 * ks + 16 + 4 * g4) * 2);
                    const bf16x8 a = __builtin_shufflevector(lo, hi, 0, 1, 2, 3, 4, 5, 6, 7);
#pragma unroll
                    for (int n = 0; n < 3; ++n) nacc[n] = MFMA16(a, Cb[ks][n], nacc[n]);
                }
#pragma unroll
                for (int r = 0; r < 4; ++r) { const float e = EB[c * 64 + 16 * m + 4 * g4 + r];
#pragma unroll
                    for (int n = 0; n < 3; ++n) nacc[n][r] *= e; }
#pragma unroll
                for (int ks = 0; ks < 2; ++ks) { const bf16x8 a = *(const LAS bf16x8*)(lds + ML_PI + (16 * m + c16) * PSTR + (32 * ks + 8 * g4) * 2);
#pragma unroll
                    for (int n = 0; n < 3; ++n) nacc[n] = MFMA16(a, bV[ks][n], nacc[n]); }
#pragma unroll
                for (int r = 0; r < 4; ++r) { const float dn = __shfl(nacc[2][r], lane & 48); const float inv = 1.0f / fmaxf(fabsf(dn), 1.0f);
                    LAS float* hp = HT + (16 * m + 4 * g4 + r) * HSTR + 32 * wave + c16;
                    hp[0] = nacc[0][r] * inv; hp[16] = nacc[1][r] * inv; }
            }
        }
        {   int tzu = tid; asm volatile("" : "+v"(tzu)); const int lane = tzu & 63, g4 = lane >> 4, q4 = (lane & 15) >> 2, p4 = lane & 3, c16 = lane & 15, vrow = tzu >> 3, vc8 = (tzu & 7) * 8; (void)q4; (void)p4; (void)c16; (void)vrow; (void)vc8; (void)g4;
#pragma unroll
        for (int ks = 0; ks < 2; ++ks)
#pragma unroll
            for (int i = 0; i < 8; ++i) { const LAS unsigned char* a0 = lds + ML_KI + (32 * ks + 8 * g4 + q4) * QSTR + (16 * i + 4 * p4) * 2;
                const bf16x8 a = tr_frag(a0, a0 + 4 * QSTR);
#pragma unroll
                for (int n = 0; n < 3; ++n) Cacc[i][n] = MFMA16(a, bV[ks][n], Cacc[i][n]);
                if ((i & 3) == 3) __builtin_amdgcn_sched_barrier(0); }
        { const float eg = EG[c];
#pragma unroll
          for (int i = 0; i < 8; ++i)
#pragma unroll
              for (int n = 0; n < 3; ++n) Cacc[i][n] *= eg; }
        if (FULL) { if (c + 1 < 8) ML_LOAD(c + 1); }
        }
        __syncthreads();
        if (FULL) {
            int tzh = tid; asm volatile("" : "+v"(tzh)); const int lane = tzh & 63, g4 = lane >> 4, q4 = (lane & 15) >> 2, p4 = lane & 3, c16 = lane & 15, vrow = tzh >> 3, vc8 = (tzh & 7) * 8; (void)q4; (void)p4; (void)c16; (void)vrow; (void)vc8; (void)g4;
            const int t = 8 * wave + (lane >> 3), part = lane & 7;
            v4u sog[4];
            { const bf16* sp = SO + (Rc + t) * MW + h * 256 + part * 32;
#pragma unroll
              for (int i = 0; i < 4; ++i) sog[i] = *(const v4u*)(sp + 8 * i); }
            float s1 = 0.f, s2 = 0.f;
#pragma unroll
            for (int i = 0; i < 8; ++i) { const f32x4 x = *(const LAS f32x4*)(HT + t * HSTR + part * 32 + i * 4); s1 += (x.x + x.y) + (x.z + x.w); s2 += (x.x * x.x + x.y * x.y) + (x.z * x.z + x.w * x.w); }
#pragma unroll
            for (int o = 1; o < 8; o <<= 1) { s1 += __shfl_xor(s1, o); s2 += __shfl_xor(s2, o); }
            const float mean = s1 * (1.0f / 256.0f); const float var = fmaxf(s2 * (1.0f / 256.0f) - mean * mean, 0.f); const float rs = 1.0f / sqrtf(var + EPS);
            const size_t offh = (Rc + t) * HZW + h * 256 + part * 32; const LAS float* gp = (const LAS float*)(lds + ML_GN) + part * 32;
#pragma unroll
            for (int i = 0; i < 4; ++i) { const v4u so = sog[i]; f32x4 sa, sb; { sa = (f32x4){__uint_as_float(so.x << 16), __uint_as_float(so.x & 0xffff0000u), __uint_as_float(so.y << 16), __uint_as_float(so.y & 0xffff0000u)}; sb = (f32x4){__uint_as_float(so.z << 16), __uint_as_float(so.z & 0xffff0000u), __uint_as_float(so.w << 16), __uint_as_float(so.w & 0xffff0000u)}; }
                const f32x4 ga = *(const LAS f32x4*)(gp + 8 * i), gb = *(const LAS f32x4*)(gp + 8 * i + 4);
                const f32x4 va = *(const LAS f32x4*)(HT + t * HSTR + part * 32 + 8 * i), vb = *(const LAS f32x4*)(HT + t * HSTR + part * 32 + 8 * i + 4);
                const f32x4 oa = (va - mean) * rs * ga * sa, ob = (vb - mean) * rs * gb * sb;
                v4u w; w.x = pk2(oa.x, oa.y); w.y = pk2(oa.z, oa.w); w.z = pk2(ob.x, ob.y); w.w = pk2(ob.z, ob.w);
                *(v4u*)(HG + offh + 8 * i) = w; }
        }
    }
#undef ML_LOAD
    if (!FULL) {
#pragma unroll
        for (int i = 0; i < 8; ++i) {
#pragma unroll
            for (int n = 0; n < 2; ++n) *(f32x4*)(STC + ((size_t)(i * 2 + n) * 512 + tid) * 4) = Cacc[i][n];
            if (wave == 0) *(f32x4*)(STC + 32768 + ((size_t)i * 64 + lane) * 4) = Cacc[i][2];
        }
        if (tid == 0) { float s = 0.f;
#pragma unroll
            for (int c = 0; c < 8; ++c) s += LG[c];
            STG[unit] = s; }
    }
    __syncthreads();
}

__device__ __forceinline__ void mlstm_carry(const Params& p, int bid, int G) {
    const float* STG = (const float*)(p.ws + WS_STG);
    constexpr int NV4 = (int)(ST_UNIT / 16);
    for (int e = bid * 512 + (int)threadIdx.x; e < 16 * NV4; e += G * 512) {
        const int chain = e / NV4, i = e % NV4;
        f32x4 S = (f32x4){0.f, 0.f, 0.f, 0.f};
        f32x4 cl[15];
#pragma unroll
        for (int s = 0; s < 15; ++s) cl[s] = *((const f32x4*)(p.ws + WS_ST + (size_t)(chain * 16 + s) * ST_UNIT) + i);
        float eg[15];
#pragma unroll
        for (int s = 0; s < 15; ++s) eg[s] = STG[chain * 16 + s];
        asm volatile("" ::: "memory");
#pragma unroll
        for (int s = 0; s < 15; ++s) { S = __expf(eg[s]) * S + cl[s]; *((f32x4*)(p.ws + WS_ST2 + (size_t)(chain * 16 + s + 1) * ST_UNIT) + i) = S; }
    }
}


constexpr size_t WS_S5T = WS_END, WS_S5C = WS_S5T + 8 * MiB, WS_S5B = WS_S5C + 4 * MiB, WS_S5L = WS_S5B + 4 * MiB, WS_END2 = WS_S5L + 1 * MiB;
static_assert(WS_END2 <= WS_A8, "ws map");
constexpr size_t WS_XL = WS_Y32 + 100 * MiB;
constexpr size_t WS_XP = WS_Y32 + 132 * MiB;
constexpr int TSTR = 528, CSTR = 272;

__device__ __forceinline__ void s5_matrices(const Params& p, int l, int g, LAS unsigned char* lds, int tid) {
    LAS float* LPr = (LAS float*)lds; LAS float* LPi = LPr + 17 * 64; LAS float* Bbr = LPi + 17 * 64; LAS float* Bbi = Bbr + 1024;
    LAS float* Cr = Bbi + 1024; LAS float* Ci = Cr + 1024; LAS float* KM = Ci + 1024;
    const int lg = l * S5G + g;
    if (tid < 64) {
        const float lre = fminf(p.in[11][lg * 64 + tid], -1e-4f), lim = p.in[12][lg * 64 + tid], dt = expf(p.in[13][lg]);
        const float mag = expf(lre * dt), ang = lim * dt; const float br = mag * cosf(ang), bi = mag * sinf(ang);
        const float den = lre * lre + lim * lim, nr = br - 1.0f; const float rr = (nr * lre + bi * lim) / den, ri = (bi * lre - nr * lim) / den;
        float pr = 1.f, pi = 0.f;
        for (int t = 0; t <= 16; ++t) { LPr[t * 64 + tid] = pr; LPi[t * 64 + tid] = pi; const float a = pr * br - pi * bi, b2 = pr * bi + pi * br; pr = a; pi = b2; }
        const float* bre = p.in[14] + ((size_t)lg * 64 + tid) * 16; const float* bim = p.in[15] + ((size_t)lg * 64 + tid) * 16;
        for (int m = 0; m < 16; ++m) { const float b_r = bre[m], b_i = bim[m]; Bbr[tid * 16 + m] = rr * b_r - ri * b_i; Bbi[tid * 16 + m] = rr * b_i + ri * b_r; }
    }
    for (int e = tid; e < 1024; e += 512) { Cr[e] = p.in[16][(size_t)lg * 1024 + e]; Ci[e] = p.in[17][(size_t)lg * 1024 + e]; }
    __syncthreads();
    if (tid < 64) ((float2*)(p.ws + WS_S5L))[g * 64 + tid] = make_float2(LPr[16 * 64 + tid], LPi[16 * 64 + tid]);
    for (int e = tid; e < 4096; e += 512) { const int tau = e >> 8, n = (e >> 4) & 15, m = e & 15; float acc = 0.f;
        for (int q = 0; q < 64; ++q) { const float cr = Cr[n * 64 + q], ci = Ci[n * 64 + q], lr = LPr[tau * 64 + q], li = LPi[tau * 64 + q];
            const float clr = cr * lr - ci * li, cli = cr * li + ci * lr; acc += clr * Bbr[q * 16 + m] - cli * Bbi[q * 16 + m]; }
        KM[e] = acc; }
    __syncthreads();
    bf16* TO = (bf16*)(p.ws + WS_S5T) + (size_t)g * 65536; bf16* CPm = (bf16*)(p.ws + WS_S5C) + (size_t)g * 32768; bf16* BPm = (bf16*)(p.ws + WS_S5B) + (size_t)g * 32768;
    for (int ck = tid; ck < 8192; ck += 512) { const int row = ck >> 5, k0 = (ck & 31) * 8, s = k0 >> 4, m0 = k0 & 15, t = row >> 4, n = row & 15; float v[8];
#pragma unroll
        for (int e = 0; e < 8; ++e) v[e] = (s <= t) ? KM[(t - s) * 256 + n * 16 + m0 + e] : 0.f;
        v4u o; o.x = pk2(v[0], v[1]); o.y = pk2(v[2], v[3]); o.z = pk2(v[4], v[5]); o.w = pk2(v[6], v[7]); *(v4u*)(TO + (size_t)row * 256 + k0) = o; }
    for (int ck = tid; ck < 4096; ck += 512) { const int row = ck >> 4, k0 = (ck & 15) * 8, part = k0 >> 6, p0 = k0 & 63, t = row >> 4, n = row & 15; float v[8];
#pragma unroll
        for (int e = 0; e < 8; ++e) { const int q = p0 + e; const float cr = Cr[n * 64 + q], ci = Ci[n * 64 + q], lr = LPr[(t + 1) * 64 + q], li = LPi[(t + 1) * 64 + q]; v[e] = part ? -(cr * li + ci * lr) : (cr * lr - ci * li); }
        v4u o; o.x = pk2(v[0], v[1]); o.y = pk2(v[2], v[3]); o.z = pk2(v[4], v[5]); o.w = pk2(v[6], v[7]); *(v4u*)(CPm + (size_t)row * 128 + k0) = o; }
    for (int ck = tid; ck < 4096; ck += 512) { const int row = ck >> 5, k0 = (ck & 31) * 8, s = k0 >> 4, m0 = k0 & 15, part = row >> 6, q = row & 63, tau = 15 - s; float v[8];
        const float lr = LPr[tau * 64 + q], li = LPi[tau * 64 + q];
#pragma unroll
        for (int e = 0; e < 8; ++e) { const float b_r = Bbr[q * 16 + m0 + e], b_i = Bbi[q * 16 + m0 + e]; v[e] = part ? (lr * b_i + li * b_r) : (lr * b_r - li * b_i); }
        v4u o; o.x = pk2(v[0], v[1]); o.y = pk2(v[2], v[3]); o.z = pk2(v[4], v[5]); o.w = pk2(v[6], v[7]); *(v4u*)(BPm + (size_t)row * 256 + k0) = o; }
    __syncthreads();
}

__device__ __forceinline__ void s5_local(const Params& p, int unit, LAS unsigned char* lds, int tid_, int wave) {
    int tid = tid_; asm volatile("" : "+v"(tid));
    const int lane = tid & 63, g4 = lane >> 4, c16 = lane & 15;
    const int chain = unit >> 1, hf = unit & 1, b = chain >> 6, g = chain & 63;
    const bf16* U = (const bf16*)(p.ws + WS_U); float* XL = (float*)(p.ws + WS_XL);
    { const unsigned char* src = p.ws + WS_S5B + (size_t)g * 65536;
#pragma unroll
      for (int i = 0; i < 8; ++i) { const int ck = tid + 512 * i, row = ck >> 5, kc = ck & 31; *(LAS v4u*)(lds + row * TSTR + kc * 16) = *(const v4u*)(src + row * 512 + kc * 16); } }
    __syncthreads();
    f32x4 acc[8][2];
#pragma unroll
    for (int i = 0; i < 8; ++i) { acc[i][0] = (f32x4){0.f, 0.f, 0.f, 0.f}; acc[i][1] = (f32x4){0.f, 0.f, 0.f, 0.f}; }
    const int blk0 = 16 * (hf * 16 + 2 * wave) + c16;
#pragma unroll
    for (int ks = 0; ks < 8; ++ks) {
        bf16x8 bfr[2];
#pragma unroll
        for (int n2 = 0; n2 < 2; ++n2) bfr[n2] = *(const bf16x8*)(U + ((size_t)chain * SEQ + (blk0 + 16 * n2) * 16 + 2 * ks + (g4 >> 1)) * 16 + 8 * (g4 & 1));
#pragma unroll
        for (int mt = 0; mt < 8; ++mt) { const bf16x8 a = *(const LAS bf16x8*)(lds + (16 * mt + c16) * TSTR + (32 * ks + 8 * g4) * 2);
            acc[mt][0] = MFMA16(a, bfr[0], acc[mt][0]); acc[mt][1] = MFMA16(a, bfr[1], acc[mt][1]); }
    }
#pragma unroll
    for (int mt = 0; mt < 8; ++mt)
#pragma unroll
        for (int n2 = 0; n2 < 2; ++n2) *(f32x4*)(XL + ((size_t)chain * 512 + blk0 + 16 * n2) * 128 + 16 * mt + 4 * g4) = acc[mt][n2];
    __syncthreads();
}

__device__ __forceinline__ void s5_scan(const Params& p, int chain, LAS unsigned char* lds, int tid_, int wave) {
    int tid = tid_; asm volatile("" : "+v"(tid));
    const int lane = tid & 63, g = chain & 63;
    const float* XL = (const float*)(p.ws + WS_XL) + (size_t)chain * 512 * 128 + (size_t)(64 * wave) * 128 + lane; bf16* XP = (bf16*)(p.ws + WS_XP) + (size_t)chain * 512 * 128 + (size_t)(64 * wave) * 128 + lane;
    LAS float* Esr = (LAS float*)lds; LAS float* Esi = Esr + 512;
    float er[32], ei[32];
#define S5_LOAD_HALF(h) do { _Pragma("unroll") for (int j = 0; j < 32; ++j) { er[j] = XL[(32 * (h) + j) * 128]; ei[j] = XL[(32 * (h) + j) * 128 + 64]; } } while (0)
    S5_LOAD_HALF(1);
    asm volatile("" ::: "memory");
    const float2 lam = ((const float2*)(p.ws + WS_S5L))[g * 64 + lane];
    float x1r = er[0], x1i = ei[0];
#pragma unroll
    for (int j = 1; j < 32; ++j) { const float nr = lam.x * x1r - lam.y * x1i + er[j], ni = lam.x * x1i + lam.y * x1r + ei[j]; x1r = nr; x1i = ni; }
    asm volatile("" ::: "memory");
    S5_LOAD_HALF(0);
    float xr = er[0], xi = ei[0];
#pragma unroll
    for (int j = 1; j < 32; ++j) { const float nr = lam.x * xr - lam.y * xi + er[j], ni = lam.x * xi + lam.y * xr + ei[j]; xr = nr; xi = ni; }
    float pr = lam.x, pi = lam.y;
#pragma unroll
    for (int k = 0; k < 5; ++k) { const float nr = pr * pr - pi * pi, ni = 2.f * pr * pi; pr = nr; pi = ni; }
    Esr[wave * 64 + lane] = pr * xr - pi * xi + x1r; Esi[wave * 64 + lane] = pr * xi + pi * xr + x1i;
    __syncthreads();
    { const float nr = pr * pr - pi * pi, ni = 2.f * pr * pi; pr = nr; pi = ni; }
    xr = 0.f; xi = 0.f;
    for (int j = 0; j < wave; ++j) { const float ex = Esr[j * 64 + lane], ey = Esi[j * 64 + lane]; const float nr = pr * xr - pi * xi + ex, ni = pr * xi + pi * xr + ey; xr = nr; xi = ni; }
#pragma unroll
    for (int h = 0; h < 2; ++h) {
        if (h == 1) { asm volatile("" ::: "memory"); S5_LOAD_HALF(1); }
#pragma unroll
        for (int j = 0; j < 32; ++j) { XP[(32 * h + j) * 128] = (bf16)(pk2(xr, 0.f) & 0xffffu); XP[(32 * h + j) * 128 + 64] = (bf16)(pk2(xi, 0.f) & 0xffffu);
            const float nr = lam.x * xr - lam.y * xi + er[j], ni = lam.x * xi + lam.y * xr + ei[j]; xr = nr; xi = ni; }
    }
#undef S5_LOAD_HALF
    __syncthreads();
}

__device__ __forceinline__ void s5_final(const Params& p, int l, int unit, LAS unsigned char* lds, int tid_, int wave) {
    int tid = tid_; asm volatile("" : "+v"(tid));
    const int lane = tid & 63, g4 = lane >> 4, c16 = lane & 15;
    const int chain = unit >> 1, h2 = unit & 1, b = chain >> 6, g = chain & 63;
    const bf16* U = (const bf16*)(p.ws + WS_U); bf16* Z = (bf16*)(p.ws + WS_Z); const bf16* XP = (const bf16*)(p.ws + WS_XP) + (size_t)chain * 512 * 128;
    LAS unsigned char* ldT = lds; LAS unsigned char* ldC = lds + 128 * TSTR;
    { const unsigned char* srcT = p.ws + WS_S5T + (size_t)g * 131072 + (size_t)h2 * 128 * 512; const unsigned char* srcC = p.ws + WS_S5C + (size_t)g * 65536 + (size_t)h2 * 128 * 256;
#pragma unroll
      for (int i = 0; i < 8; ++i) { const int ck = tid + 512 * i, row = ck >> 5, kc = ck & 31; *(LAS v4u*)(ldT + row * TSTR + kc * 16) = *(const v4u*)(srcT + row * 512 + kc * 16); }
#pragma unroll
      for (int i = 0; i < 4; ++i) { const int ck = tid + 512 * i, row = ck >> 4, kc = ck & 15; *(LAS v4u*)(ldC + row * CSTR + kc * 16) = *(const v4u*)(srcC + row * 256 + kc * 16); } }
    float dsk[4];
#pragma unroll
    for (int r = 0; r < 4; ++r) dsk[r] = p.in[18][l * S5W + g * 16 + 4 * g4 + r];
    __syncthreads();
    const int nks = h2 ? 8 : 4;
#pragma unroll 1
    for (int np = 0; np < 2; ++np) {
        f32x4 acc[8][2];
#pragma unroll
        for (int i = 0; i < 8; ++i) { acc[i][0] = (f32x4){0.f, 0.f, 0.f, 0.f}; acc[i][1] = (f32x4){0.f, 0.f, 0.f, 0.f}; }
        const int blk0 = 16 * (4 * wave + 2 * np) + c16;
        bf16x8 bu[8][2], bx[4][2];
#pragma unroll
        for (int ks = 0; ks < 8; ++ks)
#pragma unroll
            for (int n2 = 0; n2 < 2; ++n2) if (ks < nks) bu[ks][n2] = *(const bf16x8*)(U + ((size_t)chain * SEQ + (blk0 + 16 * n2) * 16 + 2 * ks + (g4 >> 1)) * 16 + 8 * (g4 & 1));
#pragma unroll
        for (int ks = 0; ks < 4; ++ks)
#pragma unroll
            for (int n2 = 0; n2 < 2; ++n2) bx[ks][n2] = *(const bf16x8*)(XP + (size_t)(blk0 + 16 * n2) * 128 + 32 * ks + 8 * g4);
#pragma unroll
        for (int ks = 0; ks < 8; ++ks) if (ks < nks) {
#pragma unroll
            for (int mt = 0; mt < 8; ++mt) { const bf16x8 a = *(const LAS bf16x8*)(ldT + (16 * mt + c16) * TSTR + (32 * ks + 8 * g4) * 2);
                acc[mt][0] = MFMA16(a, bu[ks][0], acc[mt][0]); acc[mt][1] = MFMA16(a, bu[ks][1], acc[mt][1]); }
        }
#pragma unroll
        for (int ks = 0; ks < 4; ++ks) {
#pragma unroll
            for (int mt = 0; mt < 8; ++mt) { const bf16x8 a = *(const LAS bf16x8*)(ldC + (16 * mt + c16) * CSTR + (32 * ks + 8 * g4) * 2);
                acc[mt][0] = MFMA16(a, bx[ks][0], acc[mt][0]); acc[mt][1] = MFMA16(a, bx[ks][1], acc[mt][1]); }
        }
        v2u uus[8][2];
#pragma unroll
        for (int mt = 0; mt < 8; ++mt)
#pragma unroll
            for (int n2 = 0; n2 < 2; ++n2) uus[mt][n2] = *(const v2u*)(U + ((size_t)chain * SEQ + (blk0 + 16 * n2) * 16 + 8 * h2 + mt) * 16 + 4 * g4);
        asm volatile("" ::: "memory");
#pragma unroll
        for (int mt = 0; mt < 8; ++mt)
#pragma unroll
            for (int n2 = 0; n2 < 2; ++n2) { const size_t row = (size_t)b * SEQ + (blk0 + 16 * n2) * 16 + 8 * h2 + mt; const size_t off = row * S5W + g * 16 + 4 * g4;
                const v2u uu = uus[mt][n2];
                const float u4[4] = {__uint_as_float(uu.x << 16), __uint_as_float(uu.x & 0xffff0000u), __uint_as_float(uu.y << 16), __uint_as_float(uu.y & 0xffff0000u)};
                float z[4];
#pragma unroll
                for (int r = 0; r < 4; ++r) z[r] = gelu_tanh(acc[mt][n2][r] + dsk[r] * u4[r]);
                v2u w; w.x = pk2(z[0], z[1]); w.y = pk2(z[2], z[3]); *(v2u*)(Z + off) = w; }
    }
    __syncthreads();
}

__device__ __forceinline__ void layer_body(const Params& p, const int l, LAS unsigned char* lds, const XcdBarrier& bar, int wave, int G, int bid, int gw, int NGW) {
    unsigned char* ws = p.ws;
    bf16* XN = (bf16*)(ws + WS_XN); float* RS = (float*)(ws + WS_RS);
    bf16* Y16 = (bf16*)(ws + WS_Y32);

#define IN(k) (((MK_PH_MASK >> (k)) & 1) && p.ph_lo <= (k) && (k) < p.ph_hi)
#define NREP(k) ((((MK_DUP_MASK) >> (k)) & 1) ? 2 : 1)
#define FRESH() int tid = (int)threadIdx.x; asm volatile("" : "+v"(tid)); const int lane = tid & 63; (void)lane
#define SEAM(k) do { if (!(l == p.l_hi - 1 && (k) == p.ph_hi - 1)) xcd_barrier(bar); } while (0)
        if (IN(0)) { FRESH(); for (int g = bid; g < S5G; g += G) s5_matrices(p, l, g, lds, tid); _Pragma("unroll") for (int rep = 0; rep < NREP(0); ++rep) { prep_phase(p, l, lds, bid, G, wave, lane); __syncthreads(); } SEAM(0); }
        if (IN(1)) {
            { pg8::Gemm g{XN, (const bf16*)(ws + WS_WIN), M, 7168, D}; pg8::StaticOrder S; S.init(M, 7168, G, bid);
              pg8::EpiB<0> E{nullptr, 0, nullptr, nullptr, nullptr, (bf16*)(ws + WS_QK), (bf16*)(ws + WS_V), (bf16*)(ws + WS_SO), (bf16*)(ws + WS_U), (bf16*)(ws + WS_SGA), (bf16*)(ws + WS_SGB)};
              _Pragma("unroll") for (int rep = 0; rep < NREP(1); ++rep) pg8::gemm_phase<pg8::EpiB<0>, pg8::StaticOrder, true, true>(lds, g, S, E); }
            SEAM(1);
        }
        if (IN(2)) {
            FRESH();
            _Pragma("unroll") for (int rep = 0; rep < 1 + MK_DUP_ML1; ++rep) {
            for (int unit = bid; unit < 256; unit += G) mlstm_unit<false>(p, l, unit, lds, tid, lane, wave);
            __syncthreads(); }
            _Pragma("unroll") for (int rep = 0; rep < 1 + MK_DUP_S51; ++rep) {
            for (int unit = bid; unit < 256; unit += G) s5_local(p, unit, lds, tid, wave);
            __syncthreads(); }
            SEAM(2);
        }
        if (IN(3)) { FRESH();
            if (G >= 256) { if (bid >= 128) mlstm_carry(p, bid - 128, G - 128); else s5_scan(p, bid, lds, tid, wave); }
            else { mlstm_carry(p, bid, G); for (int chain = bid; chain < 128; chain += G) s5_scan(p, chain, lds, tid, wave); }
            SEAM(3); }
        if (IN(4)) {
            FRESH();
            _Pragma("unroll") for (int rep = 0; rep < 1 + MK_DUP_ML2; ++rep) {
            for (int unit = bid; unit < 256; unit += G) mlstm_unit<true>(p, l, unit, lds, tid, lane, wave);
            __syncthreads(); }
            _Pragma("unroll") for (int rep = 0; rep < 1 + MK_DUP_S52; ++rep) {
            for (int unit = bid; unit < 256; unit += G) s5_final(p, l, unit, lds, tid, wave);
            __syncthreads(); }
            SEAM(4);
        }
        if (IN(5)) {
            pg8::Gemm g{(const bf16*)(ws + WS_Z), (const bf16*)(ws + WS_WGLU), M, S5W, S5W}; pg8::StaticOrder S; S.init(M, S5W, G, bid);
            pg8::EpiB<2> E{(bf16*)(ws + WS_HG) + MW, HZW, (const bf16*)(ws + WS_Z), nullptr, p.in[20] + (size_t)l * S5W, nullptr, nullptr, nullptr, nullptr, nullptr, nullptr, S5W};
            _Pragma("unroll") for (int rep = 0; rep < NREP(5); ++rep) pg8::gemm_phase<pg8::EpiB<2>, pg8::StaticOrder, true, true>(lds, g, S, E);
            { pg8::Gemm g{(const bf16*)(ws + WS_A8), (const bf16*)(ws + WS_W8), M, 8192, D / 2}; pg8::StaticOrder S; S.init(M, 8192, G, bid);
              pg8::EpiGate8 E{ws + WS_SG8A, ws + WS_SG8B, 1.0f / (A8_SCALE * W8_SCALE)};
              pg8::gemm_phase<pg8::EpiGate8, pg8::StaticOrder, true, true, 0, 0, false, true>(lds, g, S, E); }
            SEAM(5);
        }
        if (IN(6)) {
            pg8::Gemm g{(const bf16*)(ws + WS_HG), (const bf16*)(ws + WS_WPA), M, D, HZW, MW / 64}; pg8::StaticOrder S; S.init(M, D, G, bid);
            pg8::EpiMerge E{(bf16*)(ws + WS_SGA), ws + WS_SG8A, ws + WS_SG8B, D};
            pg8::gemm_phase<pg8::EpiMerge, pg8::StaticOrder, true, true, 0, 0, true>(lds, g, S, E);
            SEAM(6);
        }
        if (IN(7)) {
            pg8::Gemm g{(const bf16*)(ws + WS_SGA), (const bf16*)(ws + WS_WOUT), M, D, D}; pg8::StaticOrder S; S.init(M, D, G, bid);
            pg8::EpiB<5> E{Y16, D, nullptr, nullptr, nullptr, nullptr, nullptr, nullptr, nullptr, nullptr, nullptr};
            _Pragma("unroll") for (int rep = 0; rep < NREP(7); ++rep) pg8::gemm_phase<pg8::EpiB<5>, pg8::StaticOrder, true, true>(lds, g, S, E);
            SEAM(7);
        }
        if (IN(8)) { FRESH(); resid_rows(nullptr, XN, Y16, p.in[2] + (size_t)l * D, true, nullptr, RS, gw, NGW, lane); SEAM(8); }
        if (IN(9)) {
            pg8::Gemm g{XN, (const bf16*)(ws + WS_WFF1), M, DFF, D}; pg8::StaticOrder S; S.init(M, DFF, G, bid);
            pg8::EpiB<1> E{(bf16*)(ws + WS_H1), DFF, nullptr, nullptr, nullptr, nullptr, nullptr, nullptr, nullptr, nullptr, nullptr};
            _Pragma("unroll") for (int rep = 0; rep < NREP(9); ++rep) pg8::gemm_phase<pg8::EpiB<1>, pg8::StaticOrder, true, true>(lds, g, S, E);
            SEAM(9);
        }
        if (IN(10)) {
            pg8::Gemm g{(const bf16*)(ws + WS_H1), (const bf16*)(ws + WS_WFF2), M, D, DFF}; pg8::StaticOrder S; S.init(M, D, G, bid);
            pg8::EpiB<5> E{Y16, D, nullptr, nullptr, nullptr, nullptr, nullptr, nullptr, nullptr, nullptr, nullptr};
            _Pragma("unroll") for (int rep = 0; rep < NREP(10); ++rep) pg8::gemm_phase<pg8::EpiB<5>, pg8::StaticOrder, true, true, MK_FF2_AUXA, 0>(lds, g, S, E);
            SEAM(10);
        }
        if (IN(11)) { FRESH();
            if (l + 1 < DEPTH) { stage_gate_w(p.in[5] + (size_t)(l + 1) * D * PW, p.in[1] + (size_t)(l + 1) * D, lds, tid); __syncthreads(); }
            resid_rows(nullptr, XN, Y16, p.in[4] + (size_t)l * D, l + 1 < DEPTH, (l + 1 < DEPTH) ? nullptr : p.out, RS, gw, NGW, lane, nullptr, nullptr, ws + WS_A8, lds, (l + 1 < DEPTH) ? (float*)(ws + WS_GATES) : nullptr); __syncthreads(); }
#undef IN
#undef SEAM
}

__global__ void __launch_bounds__(NWAVES * 64, 2) mk_fwd(Params p) {
    extern __shared__ __attribute__((aligned(16))) unsigned char lds_raw[];
    LAS unsigned char* lds = (LAS unsigned char*)lds_raw;
    const int tid = threadIdx.x, lane = tid & 63, wave = __builtin_amdgcn_readfirstlane(tid >> 6);
    const int G = gridDim.x, bid = blockIdx.x;
    const int gw = bid * NWAVES + wave, NGW = G * NWAVES;
    for (int u = tid; u < (LDS_BYTES - LDSCTL_OFF) / 4; u += NWAVES * 64) ((LAS unsigned*)(lds + LDSCTL_OFF))[u] = 0u;
    __syncthreads();
    unsigned* ctl = (unsigned*)(p.ws + WS_CTL);
    XcdBarrier bar = xcd_barrier_post(ctl + CW_BAR + p.li * XCD_BAR_WORDS, (volatile LAS unsigned*)(lds + MISC_OFF) + 8);
    if (p.l_lo <= 0 && 0 < p.l_hi) layer_body(p, 0, lds, bar, wave, G, bid, gw, NGW);
    if (p.l_lo <= 1 && 1 < p.l_hi) layer_body(p, 1, lds, bar, wave, G, bid, gw, NGW);
}

extern "C" void kernel_launch(void* const* d_in, const int* in_sizes, int n_in, void* d_out, int out_size, void* d_ws, size_t ws_size, hipStream_t stream) {
    static int grid = 0;
    if (grid == 0) {
        if (n_in != 25 || in_sizes[0] != M * D || out_size != M * D || ws_size < WS_END3) { fprintf(stderr, "kernel_launch: unexpected shapes (n_in %d, in0 %d, out %d, ws %zu); nothing launched\n", n_in, n_in > 0 ? in_sizes[0] : -1, out_size, ws_size); grid = -1; return; }
        int dev = 0, cus = 0, per_cu = 0;
        if (hipGetDevice(&dev) != hipSuccess || hipDeviceGetAttribute(&cus, hipDeviceAttributeMultiprocessorCount, dev) != hipSuccess) { grid = -1; return; }
        if (hipFuncSetAttribute((const void*)mk_fwd, hipFuncAttributeMaxDynamicSharedMemorySize, LDS_BYTES) != hipSuccess) { fprintf(stderr, "kernel_launch: hipFuncSetAttribute failed\n"); grid = -1; return; }
        if (hipOccupancyMaxActiveBlocksPerMultiprocessor(&per_cu, (const void*)mk_fwd, NWAVES * 64, LDS_BYTES) != hipSuccess || per_cu < 1) { fprintf(stderr, "kernel_launch: occupancy query says %d blocks per CU\n", per_cu); }
        (void)hipGetLastError();
        grid = cus;
    }
    if (grid < 0) return;
    if (hipMemsetAsync((char*)d_ws + WS_CTL, 0, CTL_ZERO_BYTES, stream) != hipSuccess) { fprintf(stderr, "kernel_launch: memset failed\n"); return; }
    Params a{};
    for (int i = 0; i < 25; ++i) a.in[i] = (const float*)d_in[i];
    a.out = (float*)d_out; a.ws = (unsigned char*)d_ws; a.pad = 0;
#if MK_ONE_LAUNCH
    a.l_lo = 0; a.l_hi = DEPTH; a.ph_lo = 0; a.ph_hi = NPH; a.li = 0;
    hipLaunchKernelGGL(mk_fwd, dim3(grid), dim3(NWAVES * 64), LDS_BYTES, stream, a);
#else
    for (int l = 0; l < DEPTH; ++l)
        for (int ph = 0; ph < NPH; ++ph) { a.l_lo = l; a.l_hi = l + 1; a.ph_lo = ph; a.ph_hi = ph + 1; a.li = 0;
            hipLaunchKernelGGL(mk_fwd, dim3(grid), dim3(NWAVES * 64), LDS_BYTES, stream, a); }
#endif
    const hipError_t le = hipPeekAtLastError();
    if (le != hipSuccess) fprintf(stderr, "kernel_launch: launch failed: %s\n", hipGetErrorName(le));
}
```

```cpp
#include <hip/hip_runtime.h>
#include <cstdio>
#include <cstdint>

#ifndef MK_PH_MASK
#define MK_PH_MASK 0xfff
#endif
#ifndef MK_DUP_MASK
#define MK_DUP_MASK 0x000
#endif
#ifndef MK_DUP_ML1
#define MK_DUP_ML1 0
#endif
#ifndef MK_DUP_S51
#define MK_DUP_S51 0
#endif
#ifndef MK_DUP_ML2
#define MK_DUP_ML2 0
#endif
#ifndef MK_DUP_S52
#define MK_DUP_S52 0
#endif
#ifndef MK_FF2_AUXA
#define MK_FF2_AUXA 0
#endif
#ifndef MK_NT_STORE
#define MK_NT_STORE 0
#endif
#ifndef MK_DUP_EPI
#define MK_DUP_EPI 0
#endif
#ifndef MK_ONE_LAUNCH
#define MK_ONE_LAUNCH 1
#endif

namespace pg8 {
#define PG8_LAS __attribute__((address_space(3)))
typedef unsigned short bf16_t;
typedef short bf16x8 __attribute__((ext_vector_type(8)));
typedef float f32x4 __attribute__((ext_vector_type(4)));
typedef unsigned u32x4 __attribute__((ext_vector_type(4)));
typedef int v8i_t __attribute__((ext_vector_type(8)));
typedef short s16x16_t __attribute__((ext_vector_type(16)));
constexpr int BM = 256, BK = 64, HALF = 128, HTB = HALF * BK * 2  , STAGE_BYTES = 8 * HTB, NXCD = 8, WGM = 8;

__host__ __device__ __forceinline__ int lds_byte(int r, int c) { const int st = (r >> 4) * 2 + (c >> 5), rr = r & 15, cc = c & 31, ob = rr * 64 + cc * 2; return st * 1024 + (ob ^ (((ob >> 9) & 1) << 5)); }
__host__ __device__ __forceinline__ void stage_rc(int b, int& R, int& C) { const int st = b / 1024, sb = b % 1024, swz = sb ^ (((sb >> 9) & 1) << 5); R = (st >> 1) * 16 + swz / 64; C = (st & 1) * 32 + (swz % 64) / 2; }
__host__ __device__ __forceinline__ int perm32(int rho) { const int n = rho >> 4, i = rho & 15; return 8 * (i >> 2) + 4 * n + (i & 3); }

struct Unit { int pm, pn; };
struct Gemm { const bf16_t* A; const bf16_t* Bt; int M, N, K; int ksplit; };

struct StaticOrder {
    int nM, nN, nwg, G, c;
    __host__ __device__ void init(int M, int N, int G_, int c_) { nM = M / BM; nN = N / BM; nwg = nM * nN; G = G_; c = c_; }
    __host__ __device__ bool next(int i, Unit& u) const {
        const long L = (long)i * G + c; if (L >= nwg) return false;
        int wgid = (int)L; { const int q = nwg / NXCD, r = nwg % NXCD, xcd = wgid % NXCD, off = wgid / NXCD; wgid = (xcd < r ? xcd * (q + 1) : r * (q + 1) + (xcd - r) * q) + off; }
        const int nig = WGM * nN, gid = wgid / nig, fm = gid * WGM, gsz = (nM - fm) < WGM ? (nM - fm) : WGM;
        u.pm = fm + ((wgid % nig) % gsz); u.pn = (wgid % nig) / gsz; return true;
    }
    __device__ __forceinline__ void a_ready(const Unit&) const {}
    __device__ __forceinline__ void done(const Unit&) const {}
};

__device__ __forceinline__ unsigned cvt_pk_bf16(float lo, float hi) { unsigned r; asm volatile("s_nop 0\n\tv_cvt_pk_bf16_f32 %0, %1, %2" : "=v"(r) : "v"(lo), "v"(hi)); return r; }
__device__ __forceinline__ float sigm(float x) { return __builtin_amdgcn_rcpf(1.0f + __builtin_amdgcn_exp2f(-1.44269504f * x)); }
__device__ __forceinline__ f32x4 sigm4(f32x4 v) { return (f32x4){sigm(v[0]), sigm(v[1]), sigm(v[2]), sigm(v[3])}; }
__device__ __forceinline__ void unpack8(const u32x4 w, f32x4& a, f32x4& b) {
    a = (f32x4){__uint_as_float(w.x << 16), __uint_as_float(w.x & 0xffff0000u), __uint_as_float(w.y << 16), __uint_as_float(w.y & 0xffff0000u)};
    b = (f32x4){__uint_as_float(w.z << 16), __uint_as_float(w.z & 0xffff0000u), __uint_as_float(w.w << 16), __uint_as_float(w.w & 0xffff0000u)};
}

struct EpiF32 {
    static constexpr bool PERM = false, AFTER_DRAIN = false;
    float* C; int ldc;
    __device__ __forceinline__ void operator()(const f32x4 (&acc)[2][2][4][2], const Unit& u, int wr, int wc, int fr, int fq) const {
        const int row0 = u.pm * BM + wr * 64 + fr, col0 = u.pn * BM + wc * 32 + 4 * fq;
#pragma unroll
        for (int ai = 0; ai < 2; ++ai)
#pragma unroll
            for (int m = 0; m < 4; ++m) { float* rowp = C + (size_t)(row0 + ai * HALF + m * 16) * ldc + col0;
#pragma unroll
                for (int bj = 0; bj < 2; ++bj)
#pragma unroll
                    for (int n = 0; n < 2; ++n) *(f32x4*)(rowp + bj * HALF + n * 16) = acc[ai][bj][m][n]; }
    }
};
template <int MODE> struct EpiB {
    static constexpr bool PERM = true, AFTER_DRAIN = false;
    bf16_t* O; int ldc; const bf16_t* X1; const bf16_t* X2; const float* bias;
    bf16_t *pQK, *pV, *pSO, *pU, *pGA, *pGB;
    int ldx;
    __device__ __forceinline__ void operator()(const f32x4 (&acc)[2][2][4][2], const Unit& u, int wr, int wc, int fr, int fq) const {
        bf16_t* base = O; int ld = ldc; int colt = u.pn * BM; bool act = false, isU = false;
        if (MODE == 0) {
            const int pn = u.pn;
            if (pn < 8) { base = pQK; ld = 2048; colt = pn * BM; }
            else if (pn < 16) { base = pV; ld = 2048; colt = (pn - 8) * BM; }
            else if (pn < 24) { base = pSO; ld = 2048; colt = (pn - 16) * BM; act = true; }
            else if (pn < 28) { base = pU; ld = 1024; colt = (pn - 24) * BM; isU = true; }
            else if (pn < 44) { base = pGA; ld = 4096; colt = (pn - 28) * BM; act = true; }
            else { base = pGB; ld = 4096; colt = (pn - 44) * BM; act = true; }
        }
        const int row0 = u.pm * BM + wr * 64 + fr, col0 = colt + wc * 32 + 8 * fq;
        u32x4 lx[(MODE == 2) ? 2 : 1][4][2];
        if (MODE == 2) {
#pragma unroll
            for (int ai = 0; ai < 2; ++ai)
#pragma unroll
                for (int m = 0; m < 4; ++m)
#pragma unroll
                    for (int bj = 0; bj < 2; ++bj) lx[ai][m][bj] = *(const u32x4*)(X1 + (size_t)(row0 + ai * HALF + m * 16) * ldx + col0 + bj * HALF);
            asm volatile("" ::: "memory"); }
#pragma unroll
        for (int ai = 0; ai < 2; ++ai)
#pragma unroll
            for (int m = 0; m < 4; ++m) { const size_t ro = (size_t)(row0 + ai * HALF + m * 16) * ld + col0;
#pragma unroll
                for (int bj = 0; bj < 2; ++bj) { f32x4 v0 = acc[ai][bj][m][0], v1 = acc[ai][bj][m][1]; size_t o = ro + bj * HALF;
                    if (MODE == 0) { if (act) { v0 = sigm4(v0); v1 = sigm4(v1); }
                        if (isU) { const int row = row0 + ai * HALF + m * 16, col = col0 + bj * HALF; o = ((size_t)((row >> 13) * 64 + (col >> 4)) * 8192 + (row & 8191)) * 16 + (col & 8); } }
                    if (MODE == 1) { v0 = __builtin_elementwise_max(v0, (f32x4){0.f, 0.f, 0.f, 0.f}); v1 = __builtin_elementwise_max(v1, (f32x4){0.f, 0.f, 0.f, 0.f}); v0 = v0 * v0; v1 = v1 * v1; }
                    if (MODE == 2) { const float* bp = bias + col0 + bj * HALF; const f32x4 b0 = *(const f32x4*)bp, b1 = *(const f32x4*)(bp + 4);
                        f32x4 x0, x1; unpack8(lx[(MODE == 2) ? ai : 0][m][bj], x0, x1); v0 = x0 * sigm4(v0 + b0); v1 = x1 * sigm4(v1 + b1); }
                    if (MODE == 3) { f32x4 x0, x1; unpack8(*(const u32x4*)(X1 + o), x0, x1); v0 = x0 * v0; v1 = x1 * v1; }
                    if (MODE == 4) { f32x4 x0, x1, y0, y1; unpack8(*(const u32x4*)(X1 + o), x0, x1); unpack8(*(const u32x4*)(X2 + o), y0, y1); v0 = x0 + y0 * v0; v1 = x1 + y1 * v1; }
                    u32x4 w; w.x = cvt_pk_bf16(v0[0], v0[1]); w.y = cvt_pk_bf16(v0[2], v0[3]); w.z = cvt_pk_bf16(v1[0], v1[1]); w.w = cvt_pk_bf16(v1[2], v1[3]);
                    if (MK_NT_STORE && (MODE == 0 || MODE == 1)) __builtin_nontemporal_store(w, (u32x4*)(base + o)); else *(u32x4*)(base + o) = w; } }
    }
};

__device__ __forceinline__ unsigned gate_q4(f32x4 v, float scale) {
    unsigned q[4];
#pragma unroll
    for (int j = 0; j < 4; ++j) { const float t = __builtin_fmaf(255.0f, sigm(v[j] * scale), 0.5f); const unsigned u = (unsigned)t; q[j] = u < 1u ? 1u : u; }
    return q[0] | (q[1] << 8) | (q[2] << 16) | (q[3] << 24);
}
__device__ __forceinline__ f32x4 gate_u4(unsigned w) { return (f32x4){(float)(w & 0xffu), (float)((w >> 8) & 0xffu), (float)((w >> 16) & 0xffu), (float)(w >> 24)}; }
struct EpiGate8 {
    static constexpr bool PERM = true, AFTER_DRAIN = false;
    unsigned char* pGA; unsigned char* pGB; float scale;
    __device__ __forceinline__ void operator()(const f32x4 (&acc)[2][2][4][2], const Unit& u, int wr, int wc, int fr, int fq) const {
        unsigned char* base = (u.pn < 16) ? pGA : pGB; const int colt = (u.pn & 15) * BM;
        const int row0 = u.pm * BM + wr * 64 + fr, col0 = colt + wc * 64 + 16 * fq;
#pragma unroll
        for (int ai = 0; ai < 2; ++ai)
#pragma unroll
            for (int m = 0; m < 4; ++m) { u32x4 w;
                w.x = gate_q4(acc[ai][0][m][0], scale); w.y = gate_q4(acc[ai][0][m][1], scale); w.z = gate_q4(acc[ai][1][m][0], scale); w.w = gate_q4(acc[ai][1][m][1], scale);
                *(u32x4*)(base + (size_t)(row0 + ai * HALF + m * 16) * 4096 + col0) = w; }
    }
};

struct EpiMerge {
    static constexpr bool PERM = true, AFTER_DRAIN = false;
    bf16_t* O; const unsigned char* SGA; const unsigned char* SGB; int ldc;
    __device__ __forceinline__ void mid(f32x4 (&acc)[2][2][4][2], const Unit& u, int wr, int wc, int fr, int fq) const {
        const int row0 = u.pm * BM + wr * 64 + fr, col0 = u.pn * BM + wc * 64 + 16 * fq;
        u32x4 la[2][4], lb[2][4];
#pragma unroll
        for (int ai = 0; ai < 2; ++ai)
#pragma unroll
            for (int m = 0; m < 4; ++m) { const size_t o = (size_t)(row0 + ai * HALF + m * 16) * 4096 + col0; la[ai][m] = *(const u32x4*)(SGA + o); lb[ai][m] = *(const u32x4*)(SGB + o); }
        asm volatile("" ::: "memory");
#pragma unroll
        for (int ai = 0; ai < 2; ++ai)
#pragma unroll
            for (int m = 0; m < 4; ++m)
#pragma unroll
                for (int bj = 0; bj < 2; ++bj) { const f32x4 a0 = gate_u4(la[ai][m][2 * bj]), a1 = gate_u4(la[ai][m][2 * bj + 1]), b0 = gate_u4(lb[ai][m][2 * bj]), b1 = gate_u4(lb[ai][m][2 * bj + 1]);
#pragma unroll
                    for (int j = 0; j < 4; ++j) { acc[ai][bj][m][0][j] *= a0[j] * __builtin_amdgcn_rcpf(b0[j]); acc[ai][bj][m][1][j] *= a1[j] * __builtin_amdgcn_rcpf(b1[j]); } }
        asm volatile("" ::: "memory");
    }
    __device__ __forceinline__ void operator()(const f32x4 (&acc)[2][2][4][2], const Unit& u, int wr, int wc, int fr, int fq) const {
        const int row0 = u.pm * BM + wr * 64 + fr, col0 = u.pn * BM + wc * 32 + 8 * fq, colg = u.pn * BM + wc * 64 + 16 * fq;
        u32x4 lb[2][4];
#pragma unroll
        for (int ai = 0; ai < 2; ++ai)
#pragma unroll
            for (int m = 0; m < 4; ++m) lb[ai][m] = *(const u32x4*)(SGB + (size_t)(row0 + ai * HALF + m * 16) * 4096 + colg);
        asm volatile("" ::: "memory");
#pragma unroll
        for (int ai = 0; ai < 2; ++ai)
#pragma unroll
            for (int m = 0; m < 4; ++m)
#pragma unroll
                for (int bj = 0; bj < 2; ++bj) { const size_t o = (size_t)(row0 + ai * HALF + m * 16) * ldc + col0 + bj * HALF;
                    const f32x4 v0 = acc[ai][bj][m][0] * (gate_u4(lb[ai][m][2 * bj]) * (1.0f / 255.0f)), v1 = acc[ai][bj][m][1] * (gate_u4(lb[ai][m][2 * bj + 1]) * (1.0f / 255.0f));
                    u32x4 w; w.x = cvt_pk_bf16(v0[0], v0[1]); w.y = cvt_pk_bf16(v0[2], v0[3]); w.z = cvt_pk_bf16(v1[0], v1[1]); w.w = cvt_pk_bf16(v1[2], v1[3]);
                    *(u32x4*)(O + o) = w; }
    }
};

template <class Epi, class Sched, bool ALIGN_EPI = false, bool SP2 = false, int AUXA = 0, int AUXB = 0, bool SPLIT = false, bool FP8 = false>
__device__ __forceinline__ void gemm_phase(PG8_LAS unsigned char* lds, const Gemm g, const Sched& S, const Epi& E) {
    int tid_ = threadIdx.x; asm volatile("" : "+v"(tid_));
    const int tid = tid_, wid = __builtin_amdgcn_readfirstlane(tid >> 6), lane = tid & 63, wr = wid >> 2, wc = wid & 3, fr = lane & 15, fq = lane >> 4;
    const int K = g.K; int nt = K / BK;
    unsigned voffA[2], voffB[2];
#pragma unroll
    for (int i = 0; i < 2; ++i) { int R, C; stage_rc(tid * 16 + i * 8192, R, C); const int Rb = Epi::PERM ? ((R & ~31) + perm32(R & 31)) : R;
        voffA[i] = (unsigned)(R * K + C) * 2u; voffB[i] = (unsigned)(Rb * K + C) * 2u; }
    const size_t kstep = (size_t)(BK * 2);
    const size_t hstep = (size_t)HALF * K * 2;
    const size_t tstep = 2 * hstep;
    const unsigned ldsw = (unsigned)wid * 1024u;
    const int aoff = FP8 ? lds_byte(wr * 64 + fr, fq * 16) : lds_byte(wr * 64 + fr, fq * 8), boff = FP8 ? lds_byte(wc * 32 + fr, fq * 16) : lds_byte(wc * 32 + fr, fq * 8);
#define PG8_SA(b, h) (((b) * 2 + (h)) * HTB)
#define PG8_SB(b, h) ((4 + (b) * 2 + (h)) * HTB)
#define PG8_STAGE(bufoff, gbase, voff, aux) do { _Pragma("unroll") for (int _i = 0; _i < 2; ++_i) \
        __builtin_amdgcn_global_load_lds((const unsigned*)((const char*)(gbase) + (voff)[_i]), (PG8_LAS unsigned*)(lds + (bufoff) + ldsw + _i * 8192), 16, 0, aux); } while (0)
#define PG8_LDA(dst, b, h) do { if constexpr (FP8) { _Pragma("unroll") for (int m = 0; m < 4; ++m) { const bf16x8 _p0 = *(const PG8_LAS bf16x8*)(lds + PG8_SA(b, h) + aoff + m * 2048), _p1 = *(const PG8_LAS bf16x8*)(lds + PG8_SA(b, h) + aoff + m * 2048 + 16); dst##8[m] = __builtin_bit_cast(v8i_t, __builtin_shufflevector(_p0, _p1, 0, 1, 2, 3, 4, 5, 6, 7, 8, 9, 10, 11, 12, 13, 14, 15)); } } else _Pragma("unroll") for (int m = 0; m < 4; ++m) _Pragma("unroll") for (int k = 0; k < 2; ++k) dst[m][k] = *(const PG8_LAS bf16x8*)(lds + PG8_SA(b, h) + aoff + m * 2048 + k * 1024); } while (0)
#define PG8_LDB(dst, b, h) do { if constexpr (FP8) { _Pragma("unroll") for (int n = 0; n < 2; ++n) { const bf16x8 _p0 = *(const PG8_LAS bf16x8*)(lds + PG8_SB(b, h) + boff + n * 2048), _p1 = *(const PG8_LAS bf16x8*)(lds + PG8_SB(b, h) + boff + n * 2048 + 16); dst##8[n] = __builtin_bit_cast(v8i_t, __builtin_shufflevector(_p0, _p1, 0, 1, 2, 3, 4, 5, 6, 7, 8, 9, 10, 11, 12, 13, 14, 15)); } } else _Pragma("unroll") for (int n = 0; n < 2; ++n) _Pragma("unroll") for (int k = 0; k < 2; ++k) dst[n][k] = *(const PG8_LAS bf16x8*)(lds + PG8_SB(b, h) + boff + n * 2048 + k * 1024); } while (0)
#define PG8_MMA(ai, bj, At, Bt) do { __builtin_amdgcn_s_setprio(1); if constexpr (FP8) { _Pragma("unroll") for (int m = 0; m < 4; ++m) _Pragma("unroll") for (int n = 0; n < 2; ++n) { asm volatile("v_mfma_scale_f32_16x16x128_f8f6f4 %0, %1, %2, %0, %3, %3 op_sel_hi:[0,0,0]" : "+v"(acc[ai][bj][m][n]) : "v"(Bt##8[n]), "v"(At##8[m]), "v"(sc1)); } } else _Pragma("unroll") for (int m = 0; m < 4; ++m) _Pragma("unroll") for (int n = 0; n < 2; ++n) _Pragma("unroll") for (int k = 0; k < 2; ++k) \
        acc[ai][bj][m][n] = __builtin_amdgcn_mfma_f32_16x16x32_bf16(Bt[n][k], At[m][k], acc[ai][bj][m][n], 0, 0, 0); __builtin_amdgcn_s_setprio(0); } while (0)
#define PG8_WAIT_V(n) asm volatile("s_waitcnt vmcnt(" #n ")" ::: "memory")
#define PG8_WAIT_L(n) asm volatile("s_waitcnt lgkmcnt(" #n ")" ::: "memory")
#define PG8_BAR __builtin_amdgcn_s_barrier()
#define PG8_SCHED __builtin_amdgcn_sched_barrier(0)
    Unit cur, nxt; int ui = 0;
    if (!S.next(0, cur)) return;
    if constexpr (SPLIT) nt = g.ksplit;
    f32x4 acc[2][2][4][2];
#pragma unroll
    for (int a = 0; a < 2; ++a)
#pragma unroll
        for (int b = 0; b < 2; ++b)
#pragma unroll
            for (int m = 0; m < 4; ++m)
#pragma unroll
                for (int n = 0; n < 2; ++n) acc[a][b][m][n] = (f32x4){0.f, 0.f, 0.f, 0.f};
    bf16x8 At[4][2], B0[2][2], B1[2][2];
    v8i_t At8[4], B08[2], B18[2];
    int sc1 = 0x7f7f7f7f; asm volatile("" : "+v"(sc1));
    const char* cA = (const char*)g.A + (size_t)cur.pm * tstep; const char* cB = (const char*)g.Bt + (size_t)cur.pn * tstep;
    S.a_ready(cur);
    if constexpr (SP2) {
        PG8_STAGE(PG8_SB(0, 0), cB, voffB, AUXB); PG8_STAGE(PG8_SB(0, 1), cB + hstep, voffB, AUXB); PG8_STAGE(PG8_SA(0, 0), cA, voffA, AUXA); PG8_STAGE(PG8_SA(0, 1), cA + hstep, voffA, AUXA);
        if (wr == 1) PG8_BAR;
        PG8_WAIT_V(2); PG8_BAR;
        PG8_STAGE(PG8_SB(1, 0), cB + kstep, voffB, AUXB); PG8_STAGE(PG8_SA(1, 0), cA + kstep, voffA, AUXA); PG8_STAGE(PG8_SB(1, 1), cB + hstep + kstep, voffB, AUXB);
        PG8_WAIT_V(6); PG8_BAR;
    } else {
        PG8_STAGE(PG8_SB(0, 0), cB, voffB, AUXB); PG8_STAGE(PG8_SA(0, 0), cA, voffA, AUXA); PG8_STAGE(PG8_SB(0, 1), cB + hstep, voffB, AUXB); PG8_STAGE(PG8_SA(0, 1), cA + hstep, voffA, AUXA);
        if (wr == 1) PG8_BAR;
        PG8_WAIT_V(4); PG8_BAR;
        PG8_STAGE(PG8_SB(1, 0), cB + kstep, voffB, AUXB); PG8_STAGE(PG8_SA(1, 0), cA + kstep, voffA, AUXA); PG8_STAGE(PG8_SB(1, 1), cB + hstep + kstep, voffB, AUXB);
        PG8_WAIT_V(6); PG8_BAR;
    }
    for (;;) {
        const bool has_next = SPLIT ? S.next((ui + 1) >> 1, nxt) : S.next(ui + 1, nxt);
        const size_t nko = (SPLIT && ((ui + 1) & 1)) ? (size_t)g.ksplit * kstep : 0;
        const char* nA = has_next ? (const char*)g.A + (size_t)nxt.pm * tstep + nko : cA; const char* nB = has_next ? (const char*)g.Bt + (size_t)nxt.pn * tstep + nko : cB;
        for (int t = 0; t < nt; t += 2) {
            const bool last = (t == nt - 2);
            const char* a1 = cA + (size_t)(t + 1) * kstep;
            const char* a2 = last ? nA : cA + (size_t)(t + 2) * kstep; const char* b2 = last ? nB : cB + (size_t)(t + 2) * kstep;
            const char* a3 = a2 + kstep; const char* b3 = b2 + kstep;
            if (last && has_next) S.a_ready(nxt);
            if constexpr (SP2) {
            PG8_LDB(B0, 0, 0); PG8_LDB(B1, 0, 1); PG8_SCHED; PG8_LDA(At, 0, 0); PG8_STAGE(PG8_SA(1, 1), a1 + hstep, voffA, AUXA);
            PG8_WAIT_V(8); PG8_WAIT_L(0); PG8_BAR; PG8_MMA(0, 0, At, B0); PG8_MMA(0, 1, At, B1); PG8_BAR; PG8_SCHED;
            PG8_LDA(At, 0, 1); PG8_STAGE(PG8_SB(0, 0), b2, voffB, AUXB); PG8_STAGE(PG8_SB(0, 1), b2 + hstep, voffB, AUXB); PG8_STAGE(PG8_SA(0, 0), a2, voffA, AUXA);
            PG8_WAIT_V(8); PG8_WAIT_L(0); PG8_BAR; PG8_MMA(1, 0, At, B0); PG8_MMA(1, 1, At, B1); PG8_BAR; PG8_SCHED;
            PG8_LDB(B0, 1, 0); PG8_LDB(B1, 1, 1); PG8_SCHED; PG8_LDA(At, 1, 0); PG8_STAGE(PG8_SA(0, 1), a2 + hstep, voffA, AUXA);
            PG8_WAIT_V(8); PG8_WAIT_L(0); PG8_BAR; PG8_MMA(0, 0, At, B0); PG8_MMA(0, 1, At, B1); PG8_BAR; PG8_SCHED;
            PG8_LDA(At, 1, 1); PG8_STAGE(PG8_SB(1, 0), b3, voffB, AUXB); PG8_STAGE(PG8_SB(1, 1), b3 + hstep, voffB, AUXB); PG8_STAGE(PG8_SA(1, 0), a3, voffA, AUXA);
            PG8_WAIT_V(8); PG8_WAIT_L(0); PG8_BAR; PG8_MMA(1, 0, At, B0); PG8_MMA(1, 1, At, B1); PG8_BAR; PG8_SCHED;
            } else {
            PG8_LDB(B0, 0, 0); PG8_SCHED; PG8_LDA(At, 0, 0); PG8_STAGE(PG8_SA(1, 1), a1 + hstep, voffA, AUXA);
            PG8_WAIT_L(8); PG8_BAR; PG8_WAIT_L(0); PG8_MMA(0, 0, At, B0); PG8_BAR; PG8_SCHED;
            PG8_LDB(B1, 0, 1); PG8_STAGE(PG8_SB(0, 0), b2, voffB, AUXB);
            PG8_BAR; PG8_WAIT_L(0); PG8_MMA(0, 1, At, B1); PG8_BAR;
            PG8_LDA(At, 0, 1); PG8_STAGE(PG8_SA(0, 0), a2, voffA, AUXA);
            PG8_BAR; PG8_WAIT_L(0); PG8_MMA(1, 0, At, B0); PG8_BAR; PG8_SCHED;
            PG8_STAGE(PG8_SB(0, 1), b2 + hstep, voffB, AUXB);
            PG8_WAIT_V(6); PG8_BAR; PG8_MMA(1, 1, At, B1); PG8_BAR;
            PG8_LDB(B0, 1, 0); PG8_SCHED; PG8_LDA(At, 1, 0); PG8_STAGE(PG8_SA(0, 1), a2 + hstep, voffA, AUXA);
            PG8_WAIT_L(8); PG8_BAR; PG8_WAIT_L(0); PG8_MMA(0, 0, At, B0); PG8_BAR; PG8_SCHED;
            PG8_LDB(B1, 1, 1); PG8_STAGE(PG8_SB(1, 0), b3, voffB, AUXB);
            PG8_BAR; PG8_WAIT_L(0); PG8_MMA(0, 1, At, B1); PG8_BAR;
            PG8_LDA(At, 1, 1); PG8_STAGE(PG8_SA(1, 0), a3, voffA, AUXA);
            PG8_BAR; PG8_WAIT_L(0); PG8_MMA(1, 0, At, B0); PG8_BAR; PG8_SCHED;
            PG8_STAGE(PG8_SB(1, 1), b3 + hstep, voffB, AUXB);
            PG8_WAIT_V(6); PG8_BAR; PG8_MMA(1, 1, At, B1); PG8_BAR;
            }
        }
        if constexpr (FP8) asm volatile("s_nop 15\n\ts_nop 15" ::: "memory");
        if constexpr (ALIGN_EPI) { if (wr == 0) PG8_BAR; }
        if constexpr (SPLIT) { if ((ui & 1) == 0) E.mid(acc, cur, wr, wc, fr, fq); else E(acc, cur, wr, wc, fr, fq); }
        else if constexpr (!Epi::AFTER_DRAIN) { E(acc, cur, wr, wc, fr, fq); if (MK_DUP_EPI) { asm volatile("" ::: "memory"); E(acc, cur, wr, wc, fr, fq); } S.done(cur); }
        if (!has_next) break;
        if (!SPLIT || (ui & 1)) {
#pragma unroll
        for (int a = 0; a < 2; ++a)
#pragma unroll
            for (int b = 0; b < 2; ++b)
#pragma unroll
                for (int m = 0; m < 4; ++m)
#pragma unroll
                    for (int n = 0; n < 2; ++n) acc[a][b][m][n] = (f32x4){0.f, 0.f, 0.f, 0.f};
        }
        cur = nxt; cA = nA; cB = nB; ++ui;
        if constexpr (SPLIT) nt = (ui & 1) ? (K / BK - g.ksplit) : g.ksplit;
        if constexpr (ALIGN_EPI) { if (wr == 1) PG8_BAR; }
    }
    PG8_WAIT_V(0);
    if constexpr (!ALIGN_EPI) { if (wr == 0) PG8_BAR; }
    PG8_BAR;
    if constexpr (Epi::AFTER_DRAIN) { E.fused(acc, cur, wr, wc, fr, fq, lds, wid, lane); S.done(cur); }
#undef PG8_SA
#undef PG8_SB
#undef PG8_STAGE
#undef PG8_LDA
#undef PG8_LDB
#undef PG8_MMA
#undef PG8_WAIT_V
#undef PG8_WAIT_L
#undef PG8_BAR
#undef PG8_SCHED
}
}

constexpr int NWAVES = 8;
constexpr int BATCH = 2, SEQ = 8192, D = 4096, DEPTH = 2;
constexpr int M = BATCH * SEQ;
constexpr int HEADS = 8, DK = 128, DV = 256, MW = 2048, QKW = 1024;
constexpr int S5W = 1024, S5G = 64, S5N = 16, S5P = 64;
constexpr int DFF = 16384;
constexpr int HZW = 3072;
constexpr int PW = 15376, NP = 15360;
constexpr float EPS = 1e-6f;
constexpr int NPH = 12;

constexpr size_t MiB = 1u << 20;
constexpr size_t WS_CTL = 0, CTL_ZERO_BYTES = 1 * MiB;
constexpr size_t WS_GATES = 1 * MiB;
constexpr size_t WS_RS = 2 * MiB;
constexpr size_t WS_WIN = 4 * MiB, WS_WPA = 125 * MiB  , WS_WGLU = 149 * MiB, WS_WOUT = 151 * MiB, WS_WFF1 = 183 * MiB, WS_WFF2 = 311 * MiB;
constexpr size_t WS_W8 = WS_WIN + 56 * MiB;
constexpr float A8_SCALE = 16.0f, W8_SCALE = 256.0f;
constexpr size_t WS_A8 = 1520 * MiB, WS_END3 = 1584 * MiB;
constexpr size_t WS_XN = 439 * MiB;
constexpr size_t WS_BIG = 567 * MiB;
constexpr size_t WS_SGA = WS_BIG, WS_SGB = WS_BIG + 128 * MiB, WS_QK = WS_BIG + 256 * MiB, WS_V = WS_BIG + 320 * MiB, WS_SO = WS_BIG + 384 * MiB, WS_U = WS_BIG + 448 * MiB;
constexpr size_t WS_SG8A = WS_BIG + 128 * MiB, WS_SG8B = WS_BIG + 192 * MiB;
constexpr size_t WS_H1 = WS_BIG;
constexpr size_t WS_Y32 = 1079 * MiB;
constexpr size_t WS_HG = 1335 * MiB  , WS_Z = 1431 * MiB, WS_ST = 1463 * MiB, WS_END = 1503 * MiB;
constexpr int CW_BAR = 4096;

constexpr int RING_BYTES = 131072;
constexpr int LDSCTL_OFF = 155648, MISC_OFF = LDSCTL_OFF + 320;
constexpr int LDS_BYTES = 163840;

#define LAS __attribute__((address_space(3)))
typedef unsigned short bf16;
typedef unsigned v4u __attribute__((ext_vector_type(4)));
typedef unsigned v2u __attribute__((ext_vector_type(2)));
typedef float f32x4 __attribute__((ext_vector_type(4)));
typedef short bf16x8 __attribute__((ext_vector_type(8)));
#define LDS_WAIT() asm volatile("s_waitcnt lgkmcnt(0)" ::: "memory")
__device__ __forceinline__ float bf2f(unsigned short b) { return __uint_as_float(((unsigned)b) << 16); }
__device__ __forceinline__ unsigned pk2(float lo, float hi) { return pg8::cvt_pk_bf16(lo, hi); }
__device__ __forceinline__ float sigm(float x) { return __builtin_amdgcn_rcpf(1.0f + __builtin_amdgcn_exp2f(-1.44269504f * x)); }
__device__ __forceinline__ float wave_sum(float v) {
#pragma unroll
    for (int o = 1; o < 64; o <<= 1) v += __shfl_xor(v, o);
    return v;
}

#define XB_TMO      128
#define XB_XCNT(j)  (256  + 64 * (j))
#define XB_XSUB(j)  (1280 + 64 * (j))
#define XB_XGEN(j)  (2304 + 64 * (j))
#define XB_TOP      3328
#define XB_TOPGEN   3392
#define XCD_BAR_WORDS 3456
#define XB_SPIN_CAP (1u << 18)

__device__ __forceinline__ unsigned xb_ld(unsigned* p)              { return __hip_atomic_load(p, __ATOMIC_RELAXED, __HIP_MEMORY_SCOPE_AGENT); }
__device__ __forceinline__ unsigned xb_add(unsigned* p, unsigned v) { return __hip_atomic_fetch_add(p, v, __ATOMIC_RELAXED, __HIP_MEMORY_SCOPE_AGENT); }
__device__ __forceinline__ unsigned xb_xcc_id() { return (unsigned)__builtin_amdgcn_s_getreg((3 << 11) | 20) & 0xFu; }
#define XB_SPIN(cond, bar) do { unsigned _sp = 0; while (cond) { __builtin_amdgcn_s_sleep(1); \
    if ((++_sp & 255u) == 0u) { if (xb_ld(&(bar)[XB_TMO])) break; if (_sp > XB_SPIN_CAP) { atomicAdd(&(bar)[XB_TMO], 1u); break; } } } } while (0)

struct XcdBarrier {
    unsigned* bar; unsigned x;
    volatile LAS unsigned* st;
};

__device__ __forceinline__ XcdBarrier xcd_barrier_post(unsigned* bar, volatile LAS unsigned* st) {
    XcdBarrier b; b.bar = bar; b.x = xb_xcc_id(); b.st = st;
    if (threadIdx.x == 0) (void)xb_add(&bar[XB_XCNT(b.x)], 1u);
    return b;
}
__device__ __forceinline__ void xcd_barrier_complete(unsigned* bar, unsigned x, unsigned& nloc, unsigned& nx) {
    const unsigned G = gridDim.x * gridDim.y * gridDim.z;
    unsigned sum, cnt, mine, sp = 0u;
    for (;;) {
        sum = 0u; cnt = 0u; mine = 0u;
#pragma unroll
        for (unsigned j = 0; j < 16; ++j) { const unsigned c = xb_ld(&bar[XB_XCNT(j)]); sum += c; cnt += (c > 0u) ? 1u : 0u; mine = (j == x) ? c : mine; }
        if (sum == G) break;
        __builtin_amdgcn_s_sleep(1);
        if ((++sp & 255u) == 0u) { if (xb_ld(&bar[XB_TMO])) break; if (sp > XB_SPIN_CAP) { atomicAdd(&bar[XB_TMO], 1u); break; } }
    }
    nloc = mine > 0u ? mine : 1u; nx = cnt > 0u ? cnt : 1u;
}

__device__ __forceinline__ void xcd_barrier(const XcdBarrier& b) {
    asm volatile("s_waitcnt vmcnt(0)" ::: "memory");
    __syncthreads();
    if (threadIdx.x == 0) {
        unsigned* bar = b.bar;
        __builtin_amdgcn_s_waitcnt(0);
        unsigned nloc = b.st[0], nx = b.st[1];
        if (nloc == 0u) { xcd_barrier_complete(bar, b.x, nloc, nx); b.st[0] = nloc; b.st[1] = nx; }
        const unsigned old = xb_add(&bar[XB_XSUB(b.x)], 1u);
        const unsigned gen = old / nloc;
        if (old + 1u == (gen + 1u) * nloc) {
            __builtin_amdgcn_fence(__ATOMIC_RELEASE, "agent");
            asm volatile("s_waitcnt vmcnt(0)" ::: "memory");
            const unsigned og = xb_add(&bar[XB_TOP], 1u);
            const unsigned tg = og / nx;
            if (og + 1u == (tg + 1u) * nx) xb_add(&bar[XB_TOPGEN], 1u);
            else XB_SPIN(xb_ld(&bar[XB_TOPGEN]) == tg, bar);
            __builtin_amdgcn_fence(__ATOMIC_ACQUIRE, "agent");
            xb_add(&bar[XB_XGEN(b.x)], 1u);
            asm volatile("s_waitcnt vmcnt(0)" ::: "memory");
        } else {
            XB_SPIN(xb_ld(&bar[XB_XGEN(b.x)]) == gen, bar);
            __builtin_amdgcn_fence(__ATOMIC_ACQUIRE, "agent");
            asm volatile("s_waitcnt vmcnt(0)" ::: "memory");
        }
    }
    __syncthreads();
}

struct Params { const float* in[25]; float* out; unsigned char* ws; int l_lo, l_hi, ph_lo, ph_hi, li, pad; };

__device__ __forceinline__ void transpose_item(const float* W, int K, int N, int nsrc0, bf16* WT, int rdst0, LAS float* scr, int kb, int nb, int lane, const float* gk = nullptr, int pitch = 0, int koff = 0) {
    if (!pitch) pitch = K;
    const int k0 = 64 * kb, n0 = 32 * nb;
    { const int r8 = lane >> 3, c4 = (lane & 7) * 4; f32x4 v[8];
#pragma unroll
      for (int i = 0; i < 8; ++i) v[i] = *(const f32x4*)(W + (size_t)(k0 + 8 * i + r8) * N + nsrc0 + n0 + c4);
#pragma unroll
      for (int i = 0; i < 8; ++i) { LAS float* d = scr + (8 * i + r8) * 33 + c4; d[0] = v[i].x; d[1] = v[i].y; d[2] = v[i].z; d[3] = v[i].w; } }
    LDS_WAIT(); asm volatile("" ::: "memory");
    const int c = lane & 7;
    f32x4 ga = (f32x4){1.f, 1.f, 1.f, 1.f}, gb = ga; if (gk) { ga = *(const f32x4*)(gk + k0 + 8 * c); gb = *(const f32x4*)(gk + k0 + 8 * c + 4); }
#pragma unroll
    for (int j = 0; j < 4; ++j) { const int n = (lane >> 3) + 8 * j; const LAS float* s = scr + (8 * c) * 33 + n;
        v4u o; o.x = pk2(s[0 * 33] * ga.x, s[1 * 33] * ga.y); o.y = pk2(s[2 * 33] * ga.z, s[3 * 33] * ga.w); o.z = pk2(s[4 * 33] * gb.x, s[5 * 33] * gb.y); o.w = pk2(s[6 * 33] * gb.z, s[7 * 33] * gb.w);
        *(v4u*)(WT + (size_t)(rdst0 + n0 + n) * pitch + koff + k0 + 8 * c) = o; }
    LDS_WAIT(); asm volatile("" ::: "memory");
}

__device__ __forceinline__ unsigned pk4_fp8(float a, float b, float c, float d) { unsigned w = __builtin_amdgcn_cvt_pk_fp8_f32(a, b, 0u, false); return __builtin_amdgcn_cvt_pk_fp8_f32(c, d, w, true); }
__device__ __forceinline__ void transpose_item8(const float* W, int K, int N, int nsrc0, unsigned char* W8, int rdst0, LAS float* scr, int kb, int nb, int lane, const float* gk, float scale) {
    const int k0 = 64 * kb, n0 = 32 * nb;
    { const int r8 = lane >> 3, c4 = (lane & 7) * 4; f32x4 v[8];
#pragma unroll
      for (int i = 0; i < 8; ++i) v[i] = *(const f32x4*)(W + (size_t)(k0 + 8 * i + r8) * N + nsrc0 + n0 + c4);
#pragma unroll
      for (int i = 0; i < 8; ++i) { LAS float* d = scr + (8 * i + r8) * 33 + c4; d[0] = v[i].x; d[1] = v[i].y; d[2] = v[i].z; d[3] = v[i].w; } }
    LDS_WAIT(); asm volatile("" ::: "memory");
    const int c = lane & 7;
    const f32x4 ga = *(const f32x4*)(gk + k0 + 8 * c) * scale, gb = *(const f32x4*)(gk + k0 + 8 * c + 4) * scale;
#pragma unroll
    for (int j = 0; j < 4; ++j) { const int n = (lane >> 3) + 8 * j; const LAS float* s = scr + (8 * c) * 33 + n;
        v2u o; o.x = pk4_fp8(s[0 * 33] * ga.x, s[1 * 33] * ga.y, s[2 * 33] * ga.z, s[3 * 33] * ga.w); o.y = pk4_fp8(s[4 * 33] * gb.x, s[5 * 33] * gb.y, s[6 * 33] * gb.z, s[7 * 33] * gb.w);
        *(v2u*)(W8 + (size_t)(rdst0 + n0 + n) * K + k0 + 8 * c) = o; }
    LDS_WAIT(); asm volatile("" ::: "memory");
}

__device__ __forceinline__ void unpack8f(const v4u w, f32x4& a, f32x4& b) {
    a = (f32x4){__uint_as_float(w.x << 16), __uint_as_float(w.x & 0xffff0000u), __uint_as_float(w.y << 16), __uint_as_float(w.y & 0xffff0000u)};
    b = (f32x4){__uint_as_float(w.z << 16), __uint_as_float(w.z & 0xffff0000u), __uint_as_float(w.w << 16), __uint_as_float(w.w & 0xffff0000u)};
}
__device__ __forceinline__ void resid_rows(const float* xf, bf16* XB, const bf16* y, const float* gpost, bool xb_out, float* out32, float* RN, int gw, int ngw, int lane, bf16* XBo = nullptr, float* RNo = nullptr, unsigned char* A8 = nullptr) {
    if (!XBo) XBo = XB; if (!RNo) RNo = RN;
    for (int m = gw; m < M; m += ngw) {
        f32x4 xv[16];
        if (xf) { const f32x4* xr = (const f32x4*)(xf + (size_t)m * D) + 2 * lane;
#pragma unroll
            for (int j = 0; j < 8; ++j) { xv[2 * j] = xr[128 * j]; xv[2 * j + 1] = xr[128 * j + 1]; } }
        else { const v4u* xr = (const v4u*)(XB + (size_t)m * D) + lane; const float rn = RN[m];
#pragma unroll
            for (int j = 0; j < 8; ++j) { unpack8f(xr[64 * j], xv[2 * j], xv[2 * j + 1]); xv[2 * j] = xv[2 * j] * rn; xv[2 * j + 1] = xv[2 * j + 1] * rn; } }
        if (y) {
            f32x4 yv[16]; float ss = 0.f;
            const v4u* yr = (const v4u*)(y + (size_t)m * D) + lane;
#pragma unroll
            for (int j = 0; j < 8; ++j) unpack8f(yr[64 * j], yv[2 * j], yv[2 * j + 1]);
#pragma unroll
            for (int j = 0; j < 16; ++j) ss += (yv[j].x * yv[j].x + yv[j].y * yv[j].y) + (yv[j].z * yv[j].z + yv[j].w * yv[j].w);
            const float rstd = 1.0f / sqrtf(wave_sum(ss) * (1.0f / D) + EPS);
#pragma unroll
            for (int j = 0; j < 8; ++j) {
#pragma unroll
                for (int k = 0; k < 2; ++k) { const f32x4 g = ((const f32x4*)gpost)[2 * lane + 128 * j + k]; xv[2 * j + k] = xv[2 * j + k] + yv[2 * j + k] * rstd * g; } }
        }
        if (out32) { f32x4* xo = (f32x4*)(out32 + (size_t)m * D) + 2 * lane;
#pragma unroll
            for (int j = 0; j < 8; ++j) { xo[128 * j] = xv[2 * j]; xo[128 * j + 1] = xv[2 * j + 1]; } }
        if (xb_out) {
            float s2 = 0.f;
#pragma unroll
            for (int j = 0; j < 16; ++j) s2 += (xv[j].x * xv[j].x + xv[j].y * xv[j].y) + (xv[j].z * xv[j].z + xv[j].w * xv[j].w);
            const float ms = wave_sum(s2) * (1.0f / D) + EPS; const float rs2 = 1.0f / sqrtf(ms);
            v4u* o16 = (v4u*)(XBo + (size_t)m * D) + lane;
#pragma unroll
            for (int j = 0; j < 8; ++j) { const f32x4 a = xv[2 * j] * rs2, b = xv[2 * j + 1] * rs2; v4u w; w.x = pk2(a.x, a.y); w.y = pk2(a.z, a.w); w.z = pk2(b.x, b.y); w.w = pk2(b.z, b.w); o16[64 * j] = w; }
            if (A8) { v2u* o8 = (v2u*)(A8 + (size_t)m * D) + lane; const float s8 = rs2 * A8_SCALE;
#pragma unroll
                for (int j = 0; j < 8; ++j) { const f32x4 a = xv[2 * j] * s8, b = xv[2 * j + 1] * s8; v2u w; w.x = pk4_fp8(a.x, a.y, a.z, a.w); w.y = pk4_fp8(b.x, b.y, b.z, b.w); o8[64 * j] = w; } }
            if (lane == 0) RNo[m] = sqrtf(ms); }
    }
}

__device__ __forceinline__ void gates_phase(const bf16* XN, const bf16* Wg, float* GATES, LAS unsigned char* lds, int gw, int ngw, int wave, int lane) {
    LAS f32x4* red = (LAS f32x4*)lds;
    for (int u = gw; u < M / 8; u += ngw) {
        const int row0 = (u >> 1) * 16, kh = u & 1; f32x4 acc0 = (f32x4){0.f, 0.f, 0.f, 0.f}, acc1 = acc0;
        const bf16* ap = XN + (size_t)(row0 + (lane & 15)) * D + kh * (D / 2) + (lane >> 4) * 8;
        const bf16* bp = Wg + (size_t)(lane & 15) * D + kh * (D / 2) + (lane >> 4) * 8;
#pragma unroll 1
        for (int kb = 0; kb < 4; ++kb) {
            bf16x8 a[16], b[16];
#pragma unroll
            for (int kk = 0; kk < 16; ++kk) { a[kk] = *(const bf16x8*)(ap + (kb * 16 + kk) * 32); b[kk] = *(const bf16x8*)(bp + (kb * 16 + kk) * 32); }
#pragma unroll
            for (int kk = 0; kk < 16; kk += 2) { acc0 = __builtin_amdgcn_mfma_f32_16x16x32_bf16(a[kk], b[kk], acc0, 0, 0, 0); acc1 = __builtin_amdgcn_mfma_f32_16x16x32_bf16(a[kk + 1], b[kk + 1], acc1, 0, 0, 0); }
        }
        f32x4 s = acc0 + acc1;
        if (kh) red[(wave >> 1) * 64 + lane] = s;
        __syncthreads();
        if (!kh) { s += red[(wave >> 1) * 64 + lane];
#pragma unroll
            for (int r = 0; r < 4; ++r) GATES[(size_t)(row0 + 4 * (lane >> 4) + r) * 16 + (lane & 15)] = s[r]; }
        __syncthreads();
    }
}

__device__ __forceinline__ float gelu_tanh(float x) { return x * sigm(1.5957691216057308f * (x + 0.044715f * x * x * x)); }

struct TItem { const float* W; int N, nsrc0, k0, n0; unsigned char* dst; int pitchB, esz; const float* gk; float scale; };
__device__ __forceinline__ void titem_load(const TItem& I, f32x4 (&v)[8], int lane) {
    const int r8 = lane >> 3, c4 = (lane & 7) * 4;
#pragma unroll
    for (int i = 0; i < 8; ++i) v[i] = *(const f32x4*)(I.W + (size_t)(I.k0 + 8 * i + r8) * I.N + I.nsrc0 + I.n0 + c4);
}
__device__ __forceinline__ void titem_to_lds(const f32x4 (&v)[8], LAS float* scr, int lane) {
    const int r8 = lane >> 3, c4 = (lane & 7) * 4;
#pragma unroll
    for (int i = 0; i < 8; ++i) { LAS float* d = scr + (8 * i + r8) * 33 + c4; d[0] = v[i].x; d[1] = v[i].y; d[2] = v[i].z; d[3] = v[i].w; }
}
__device__ __forceinline__ void titem_store(const TItem& I, LAS float* scr, int lane) {
    const int c = lane & 7;
    f32x4 ga = (f32x4){I.scale, I.scale, I.scale, I.scale}, gb = ga; if (I.gk) { ga = *(const f32x4*)(I.gk + I.k0 + 8 * c) * I.scale; gb = *(const f32x4*)(I.gk + I.k0 + 8 * c + 4) * I.scale; }
#pragma unroll
    for (int j = 0; j < 4; ++j) { const int n = (lane >> 3) + 8 * j; const LAS float* s = scr + (8 * c) * 33 + n;
        const float e0 = s[0 * 33] * ga.x, e1 = s[1 * 33] * ga.y, e2 = s[2 * 33] * ga.z, e3 = s[3 * 33] * ga.w, e4 = s[4 * 33] * gb.x, e5 = s[5 * 33] * gb.y, e6 = s[6 * 33] * gb.z, e7 = s[7 * 33] * gb.w;
        unsigned char* d = I.dst + (size_t)(I.n0 + n) * I.pitchB + (size_t)(I.k0 + 8 * c) * I.esz;
        if (I.esz == 2) { v4u o; o.x = pk2(e0, e1); o.y = pk2(e2, e3); o.z = pk2(e4, e5); o.w = pk2(e6, e7); *(v4u*)d = o; }
        else { v2u o; o.x = pk4_fp8(e0, e1, e2, e3); o.y = pk4_fp8(e4, e5, e6, e7); *(v2u*)d = o; } }
}
__device__ __forceinline__ void prep_phase(const Params& p, int l, LAS unsigned char* lds, int bid, int G, int wave, int lane) {
    LAS float* scr = (LAS float*)(lds + wave * 16384);
    const int gw = bid * NWAVES + wave, NGW = G * NWAVES;
    const float* g_mix = p.in[1] + (size_t)l * D; const float* g_mlp = p.in[3] + (size_t)l * D;
    const float* w_in = p.in[5] + (size_t)l * D * PW; const float* p_a = p.in[10] + (size_t)l * MW * D; const float* w_glu = p.in[19] + (size_t)l * S5W * S5W;
    const float* p_b = p.in[21] + (size_t)l * S5W * D; const float* w_out = p.in[22] + (size_t)l * D * D; const float* w_ff1 = p.in[23] + (size_t)l * D * DFF; const float* w_ff2 = p.in[24] + (size_t)l * DFF * D;
    unsigned char* ws = p.ws; bf16* WIN = (bf16*)(ws + WS_WIN);
    constexpr int I_IN1 = (D / 64) * (6144 / 32), I_IN2 = (D / 64) * (1024 / 32), I_IN8 = (D / 64) * (8192 / 32), I_PA = (MW / 64) * (D / 32), I_GLU = (S5W / 64) * (S5W / 32), I_PB = (S5W / 64) * (D / 32),
                  I_OUT = (D / 64) * (D / 32), I_FF1 = (D / 64) * (DFF / 32), I_FF2 = (DFF / 64) * (D / 32);
    constexpr int NITEMS = I_IN1 + I_IN2 + I_IN8 + I_PA + I_GLU + I_PB + I_OUT + I_FF1 + I_FF2;
#define TI(W_, N_, nsrc_, nblk_, dst_, pitchB_, esz_, koffB_, gk_, sc_) do { I.W = (W_); I.N = (N_); I.nsrc0 = (nsrc_); I.k0 = 64 * (r / (nblk_)); I.n0 = 32 * (r % (nblk_)); I.dst = (dst_) + (koffB_); I.pitchB = (pitchB_); I.esz = (esz_); I.gk = (gk_); I.scale = (sc_); } while (0)
    auto decode = [&](int it, TItem& I) { int r = NITEMS - 1 - it;
        if (r < I_IN1) { TI(w_in, PW, 0, 192, ws + WS_WIN, D * 2, 2, 0, g_mix, 1.f); return; } r -= I_IN1;
        if (r < I_IN2) { TI(w_in, PW, 6160, 32, ws + WS_WIN + (size_t)6144 * D * 2, D * 2, 2, 0, g_mix, 1.f); return; } r -= I_IN2;
        if (r < I_IN8) { TI(w_in, PW, 7184, 256, ws + WS_W8, D, 1, 0, g_mix, W8_SCALE); return; } r -= I_IN8;
        if (r < I_PA) { TI(p_a, D, 0, 128, ws + WS_WPA, HZW * 2, 2, 0, nullptr, 1.f); return; } r -= I_PA;
        if (r < I_GLU) { TI(w_glu, S5W, 0, 32, ws + WS_WGLU, S5W * 2, 2, 0, nullptr, 1.f); return; } r -= I_GLU;
        if (r < I_PB) { TI(p_b, D, 0, 128, ws + WS_WPA, HZW * 2, 2, MW * 2, nullptr, 1.f); return; } r -= I_PB;
        if (r < I_OUT) { TI(w_out, D, 0, 128, ws + WS_WOUT, D * 2, 2, 0, nullptr, 1.f); return; } r -= I_OUT;
        if (r < I_FF1) { TI(w_ff1, DFF, 0, 512, ws + WS_WFF1, D * 2, 2, 0, g_mlp, 1.f); return; } r -= I_FF1;
        TI(w_ff2, D, 0, 128, ws + WS_WFF2, DFF * 2, 2, 0, nullptr, 1.f); };
    if (gw < NITEMS) {
        TItem cur, nxt; f32x4 v[8];
        decode(gw, cur); titem_load(cur, v, lane);
        for (int it = gw; it < NITEMS; it += NGW) {
            titem_to_lds(v, scr, lane);
            const bool more = it + NGW < NITEMS;
            if (more) { decode(it + NGW, nxt); titem_load(nxt, v, lane); }
            LDS_WAIT(); asm volatile("" ::: "memory");
            titem_store(cur, scr, lane);
            LDS_WAIT(); asm volatile("" ::: "memory");
            if (more) cur = nxt;
        }
    }
#undef TI
    for (int e = bid * 512 + (int)threadIdx.x; e < 16 * D; e += G * 512) { const int j = e & 15, k = e >> 4; WIN[(size_t)(NP + j) * D + k] = (bf16)(pk2(w_in[(size_t)k * PW + 6144 + j] * g_mix[k], 0.f) & 0xffffu); }
    if (l == 0) resid_rows(p.in[0], (bf16*)(p.ws + WS_XN), nullptr, nullptr, true, nullptr, (float*)(p.ws + WS_RS), gw, NGW, lane, nullptr, nullptr, p.ws + WS_A8);
}

typedef short s16x4 __attribute__((ext_vector_type(4)));
#define MFMA16(a, b, c) __builtin_amdgcn_mfma_f32_16x16x32_bf16(a, b, c, 0, 0, 0)
constexpr int ML_QI = 0, ML_KI = 17408, ML_VI = 34816, ML_PI = 70656, ML_EB = 79872, ML_EKW = 81920, ML_EG = 83968, ML_LG = 84000, ML_HT = 84480, ML_GN = 151040;
constexpr int QSTR = 272, VSTR = 560, PSTR = 144, HSTR = 260;
constexpr size_t ST_UNIT = 139264;
constexpr size_t WS_STG = WS_ST + 256 * ST_UNIT;
static_assert(WS_STG + 4096 <= WS_END, "ws map");
constexpr size_t WS_QKC = WS_Y32;
constexpr size_t WS_ST2 = WS_Y32 + 64 * MiB;

__device__ __forceinline__ bf16x8 tr_frag(const LAS unsigned char* p0, const LAS unsigned char* p1) {
    const s16x4 a = __builtin_amdgcn_ds_read_tr16_b64_v4i16((LAS s16x4*)p0), b = __builtin_amdgcn_ds_read_tr16_b64_v4i16((LAS s16x4*)p1);
    return __builtin_shufflevector(a, b, 0, 1, 2, 3, 4, 5, 6, 7);
}
__device__ __forceinline__ bf16x8 pack8(const f32x4 a, const f32x4 b) { v4u w; w.x = pk2(a.x, a.y); w.y = pk2(a.z, a.w); w.z = pk2(b.x, b.y); w.w = pk2(b.z, b.w); return __builtin_bit_cast(bf16x8, w); }

template <bool FULL>
__device__ __forceinline__ void mlstm_unit(const Params& p, int l, int unit, LAS unsigned char* lds, int tid_, int lane_, int wave) {
    int tid = tid_; asm volatile("" : "+v"(tid));
    const int lane = tid & 63; (void)lane_;
    const int b = unit >> 7, h = (unit >> 4) & 7, seg = unit & 15;
    const bf16* QK = (const bf16*)(p.ws + WS_QK); const bf16* V = (const bf16*)(p.ws + WS_V); const float* GATES = (const float*)(p.ws + WS_GATES);
    bf16* QKC = (bf16*)(p.ws + WS_QKC); const bf16* SO = (const bf16*)(p.ws + WS_SO); bf16* HG = (bf16*)(p.ws + WS_HG);
    float* STC = (float*)(p.ws + WS_ST + (size_t)unit * ST_UNIT); float* STG = (float*)(p.ws + WS_STG);
    LAS float* EB = (LAS float*)(lds + ML_EB); LAS float* EKW = (LAS float*)(lds + ML_EKW); LAS float* EG = (LAS float*)(lds + ML_EG); LAS float* LG = (LAS float*)(lds + ML_LG);
    LAS float* HT = (LAS float*)(lds + ML_HT);
    const int g4 = lane >> 4, q4 = (lane & 15) >> 2, p4 = lane & 3, c16 = lane & 15;
    const size_t rowb = (size_t)b * SEQ; const int t0 = seg * 512;
    { const size_t row = rowb + t0 + wave * 64 + lane;
      const float ip = GATES[row * 16 + h] + p.in[7][l * 8 + h], fp = GATES[row * 16 + 8 + h] + p.in[8][l * 8 + h];
      float bsum = -log1pf(__expf(-fp));
#pragma unroll
      for (int o = 1; o < 64; o <<= 1) { const float t = __shfl_up(bsum, o); if (lane >= o) bsum += t; }
      EB[wave * 64 + lane] = __expf(bsum); EKW[wave * 64 + lane] = __expf(ip - bsum);
      if (lane == 63) { EG[wave] = __expf(bsum); LG[wave] = bsum; } }
    f32x4 Cacc[8][3];
#pragma unroll
    for (int i = 0; i < 8; ++i)
#pragma unroll
        for (int j = 0; j < 3; ++j) Cacc[i][j] = (f32x4){0.f, 0.f, 0.f, 0.f};
    if (FULL && seg > 0) {
        const float* sj = (const float*)(p.ws + WS_ST2 + (size_t)unit * ST_UNIT);
#pragma unroll
        for (int i = 0; i < 8; ++i) {
#pragma unroll
            for (int n = 0; n < 2; ++n) Cacc[i][n] = *(const f32x4*)(sj + ((size_t)(i * 2 + n) * 512 + tid) * 4);
            Cacc[i][2] = *(const f32x4*)(sj + 32768 + ((size_t)i * 64 + lane) * 4);
        }
    }
    const int which = tid >> 8, sb = (tid >> 7) & 1, dch = tid & 127, ch = which * 1024 + h * 128 + dch;
    float cw0 = 0.f, cw1 = 0.f, cw2 = 0.f, cw3 = 0.f;
    if (!FULL) { const float* cw = p.in[6] + (size_t)l * 4 * 2048; cw0 = cw[ch]; cw1 = cw[2048 + ch]; cw2 = cw[4096 + ch]; cw3 = cw[6144 + ch]; }
    const int vrow = tid >> 3, vc8 = (tid & 7) * 8;
    unsigned short rawh[FULL ? 1 : 35]; v4u qkr[FULL ? 4 : 1]; v4u vr[4];
#define ML_LOAD(c_) do { const size_t Rl = rowb + t0 + (c_) * 64; \
        if (!FULL) { const int tq0 = t0 + (c_) * 64 + 32 * sb - 3; _Pragma("unroll") for (int i = 0; i < 35; ++i) rawh[i] = (tq0 + i >= 0) ? QK[(rowb + tq0 + i) * 2048 + ch] : (unsigned short)0; } \
        else { _Pragma("unroll") for (int i = 0; i < 2; ++i) { const int col = i * 64 + vc8; qkr[i] = *(const v4u*)(QKC + (Rl + vrow) * 2048 + h * 128 + col); qkr[2 + i] = *(const v4u*)(QKC + (Rl + vrow) * 2048 + 1024 + h * 128 + col); } } \
        _Pragma("unroll") for (int i = 0; i < 4; ++i) vr[i] = *(const v4u*)(V + (Rl + vrow) * 2048 + h * 256 + i * 64 + vc8); } while (0)
    ML_LOAD(0);
    if (FULL) { if (tid < 256) ((LAS float*)(lds + ML_GN))[tid] = p.in[9][(size_t)l * MW + h * 256 + tid]; }
    if ((tid & 7) == 0) { const v4u z = (v4u){0u, 0u, 0u, 0u}; *(LAS v4u*)(lds + ML_VI + vrow * VSTR + 512) = z; *(LAS v4u*)(lds + ML_VI + vrow * VSTR + 528) = z; }
    __syncthreads();
#pragma unroll 1
    for (int c = 0; c < 8; ++c) {
        const size_t Rc = rowb + t0 + c * 64;
        int tz = tid; asm volatile("" : "+v"(tz));
        const int lane = tz & 63, g4 = lane >> 4, q4 = (lane & 15) >> 2, p4 = lane & 3, c16 = lane & 15, vrow = tz >> 3, vc8 = (tz & 7) * 8, dch = tz & 127, sb = (tz >> 7) & 1;
        if (!FULL) {
#pragma unroll
            for (int s2 = 0; s2 < 32; ++s2) {
                const float a = cw0 * bf2f(rawh[s2]) + cw1 * bf2f(rawh[s2 + 1]) + cw2 * bf2f(rawh[s2 + 2]) + cw3 * bf2f(rawh[s2 + 3]);
                float val = a * sigm(a); if (!which) val *= 0.08838834764831845f;
                const bf16 bv = (bf16)(pk2(val, 0.f) & 0xffffu);
                QKC[(Rc + 32 * sb + s2) * 2048 + ch] = bv;
                if (which) *(LAS bf16*)(lds + ML_KI + (32 * sb + s2) * QSTR + dch * 2) = bv;
            }
        } else {
#pragma unroll
            for (int i = 0; i < 2; ++i) { const int col = i * 64 + vc8;
                *(LAS v4u*)(lds + ML_QI + vrow * QSTR + col * 2) = qkr[i];
                *(LAS v4u*)(lds + ML_KI + vrow * QSTR + col * 2) = qkr[2 + i]; }
        }
        { const float ek = EKW[c * 64 + vrow];
#pragma unroll
          for (int i = 0; i < 4; ++i) { const int col = i * 64 + vc8; const v4u w = vr[i];
              v4u o; o.x = pk2(__uint_as_float(w.x << 16) * ek, __uint_as_float(w.x & 0xffff0000u) * ek); o.y = pk2(__uint_as_float(w.y << 16) * ek, __uint_as_float(w.y & 0xffff0000u) * ek);
              o.z = pk2(__uint_as_float(w.z << 16) * ek, __uint_as_float(w.z & 0xffff0000u) * ek); o.w = pk2(__uint_as_float(w.w << 16) * ek, __uint_as_float(w.w & 0xffff0000u) * ek);
              *(LAS v4u*)(lds + ML_VI + vrow * VSTR + col * 2) = o; }
          if ((tid & 7) == 0) *(LAS bf16*)(lds + ML_VI + vrow * VSTR + 512) = (bf16)(pk2(ek, 0.f) & 0xffffu); }
        __syncthreads();
        if (!FULL) { if (c + 1 < 8) ML_LOAD(c + 1); }
        if (FULL) {
            const int mt = wave >> 1, ntb = 2 * (wave & 1);
            f32x4 sacc[2] = {(f32x4){0.f, 0.f, 0.f, 0.f}, (f32x4){0.f, 0.f, 0.f, 0.f}};
#pragma unroll
            for (int ks = 0; ks < 4; ++ks) { const bf16x8 a = *(const LAS bf16x8*)(lds + ML_QI + (16 * mt + c16) * QSTR + (32 * ks + 8 * g4) * 2);
#pragma unroll
                for (int n2 = 0; n2 < 2; ++n2) { const bf16x8 bb = *(const LAS bf16x8*)(lds + ML_KI + (16 * (ntb + n2) + c16) * QSTR + (32 * ks + 8 * g4) * 2); sacc[n2] = MFMA16(a, bb, sacc[n2]); } }
#pragma unroll
            for (int n2 = 0; n2 < 2; ++n2)
#pragma unroll
                for (int r = 0; r < 4; ++r) { const int t = 16 * mt + 4 * g4 + r, s = 16 * (ntb + n2) + c16;
                    const float val = (s <= t) ? sacc[n2][r] * EB[c * 64 + t] : 0.f;
                    *(LAS bf16*)(lds + ML_PI + t * PSTR + s * 2) = (bf16)(pk2(val, 0.f) & 0xffffu); }
            __syncthreads();
        }
        bf16x8 bV[2][3];
#pragma unroll
        for (int ks = 0; ks < 2; ++ks)
#pragma unroll
            for (int n = 0; n < 3; ++n) { const int col0 = (n < 2) ? (32 * wave + 16 * n) : 256;
                const LAS unsigned char* a0 = lds + ML_VI + (32 * ks + 8 * g4 + q4) * VSTR + (col0 + 4 * p4) * 2;
                bV[ks][n] = tr_frag(a0, a0 + 4 * VSTR); }
        if (FULL) {
            int tzm = tid; asm volatile("" : "+v"(tzm)); const int lane = tzm & 63, g4 = lane >> 4, q4 = (lane & 15) >> 2, p4 = lane & 3, c16 = lane & 15, vrow = tzm >> 3, vc8 = (tzm & 7) * 8; (void)q4; (void)p4; (void)c16; (void)vrow; (void)vc8; (void)g4;
            bf16x8 Cb[4][3];
#pragma unroll
            for (int ks = 0; ks < 4; ++ks)
#pragma unroll
                for (int n = 0; n < 3; ++n) Cb[ks][n] = pack8(Cacc[2 * ks][n], Cacc[2 * ks + 1][n]);
#pragma unroll 2
            for (int m = 0; m < 4; ++m) {
                f32x4 nacc[3] = {(f32x4){0.f, 0.f, 0.f, 0.f}, (f32x4){0.f, 0.f, 0.f, 0.f}, (f32x4){0.f, 0.f, 0.f, 0.f}};
#pragma unroll
                for (int ks = 0; ks < 4; ++ks) {
                    const s16x4 lo = *(const LAS s16x4*)(lds + ML_QI + (16 * m + c16) * QSTR + (32 * ks + 4 * g4) * 2), hi = *(const LAS s16x4*)(lds + ML_QI + (16 * m + c16) * QSTR + (32 * ks + 16 + 4 * g4) * 2);
                    const bf16x8 a = __builtin_shufflevector(lo, hi, 0, 1, 2, 3, 4, 5, 6, 7);
#pragma unroll
                    for (int n = 0; n < 3; ++n) nacc[n] = MFMA16(a, Cb[ks][n], nacc[n]);
                }
#pragma unroll
                for (int r = 0; r < 4; ++r) { const float e = EB[c * 64 + 16 * m + 4 * g4 + r];
#pragma unroll
                    for (int n = 0; n < 3; ++n) nacc[n][r] *= e; }
#pragma unroll
                for (int ks = 0; ks < 2; ++ks) { const bf16x8 a = *(const LAS bf16x8*)(lds + ML_PI + (16 * m + c16) * PSTR + (32 * ks + 8 * g4) * 2);
#pragma unroll
                    for (int n = 0; n < 3; ++n) nacc[n] = MFMA16(a, bV[ks][n], nacc[n]); }
#pragma unroll
                for (int r = 0; r < 4; ++r) { const float dn = __shfl(nacc[2][r], lane & 48); const float inv = __builtin_amdgcn_rcpf(fmaxf(fabsf(dn), 1.0f));
                    LAS float* hp = HT + (16 * m + 4 * g4 + r) * HSTR + 32 * wave + c16;
                    hp[0] = nacc[0][r] * inv; hp[16] = nacc[1][r] * inv; }
            }
        }
        {   int tzu = tid; asm volatile("" : "+v"(tzu)); const int lane = tzu & 63, g4 = lane >> 4, q4 = (lane & 15) >> 2, p4 = lane & 3, c16 = lane & 15, vrow = tzu >> 3, vc8 = (tzu & 7) * 8; (void)q4; (void)p4; (void)c16; (void)vrow; (void)vc8; (void)g4;
#pragma unroll
        for (int ks = 0; ks < 2; ++ks)
#pragma unroll
            for (int i = 0; i < 8; ++i) { const LAS unsigned char* a0 = lds + ML_KI + (32 * ks + 8 * g4 + q4) * QSTR + (16 * i + 4 * p4) * 2;
                const bf16x8 a = tr_frag(a0, a0 + 4 * QSTR);
#pragma unroll
                for (int n = 0; n < 3; ++n) Cacc[i][n] = MFMA16(a, bV[ks][n], Cacc[i][n]);
                if ((i & 3) == 3) __builtin_amdgcn_sched_barrier(0); }
        { const float eg = EG[c];
#pragma unroll
          for (int i = 0; i < 8; ++i)
#pragma unroll
              for (int n = 0; n < 3; ++n) Cacc[i][n] *= eg; }
        if (FULL) { if (c + 1 < 8) ML_LOAD(c + 1); }
        }
        __syncthreads();
        if (FULL) {
            int tzh = tid; asm volatile("" : "+v"(tzh)); const int lane = tzh & 63, g4 = lane >> 4, q4 = (lane & 15) >> 2, p4 = lane & 3, c16 = lane & 15, vrow = tzh >> 3, vc8 = (tzh & 7) * 8; (void)q4; (void)p4; (void)c16; (void)vrow; (void)vc8; (void)g4;
            const int t = 8 * wave + (lane >> 3), part = lane & 7;
            v4u sog[4];
            { const bf16* sp = SO + (Rc + t) * MW + h * 256 + part * 32;
#pragma unroll
              for (int i = 0; i < 4; ++i) sog[i] = *(const v4u*)(sp + 8 * i); }
            asm volatile("" ::: "memory");
            float s1 = 0.f, s2 = 0.f;
#pragma unroll
            for (int i = 0; i < 8; ++i) { const f32x4 x = *(const LAS f32x4*)(HT + t * HSTR + part * 32 + i * 4); s1 += (x.x + x.y) + (x.z + x.w); s2 += (x.x * x.x + x.y * x.y) + (x.z * x.z + x.w * x.w); }
#pragma unroll
            for (int o = 1; o < 8; o <<= 1) { s1 += __shfl_xor(s1, o); s2 += __shfl_xor(s2, o); }
            const float mean = s1 * (1.0f / 256.0f); const float var = fmaxf(s2 * (1.0f / 256.0f) - mean * mean, 0.f); const float rs = 1.0f / sqrtf(var + EPS);
            const size_t offh = (Rc + t) * HZW + h * 256 + part * 32; const LAS float* gp = (const LAS float*)(lds + ML_GN) + part * 32;
#pragma unroll
            for (int i = 0; i < 4; ++i) { const v4u so = sog[i]; f32x4 sa, sb; { sa = (f32x4){__uint_as_float(so.x << 16), __uint_as_float(so.x & 0xffff0000u), __uint_as_float(so.y << 16), __uint_as_float(so.y & 0xffff0000u)}; sb = (f32x4){__uint_as_float(so.z << 16), __uint_as_float(so.z & 0xffff0000u), __uint_as_float(so.w << 16), __uint_as_float(so.w & 0xffff0000u)}; }
                const f32x4 ga = *(const LAS f32x4*)(gp + 8 * i), gb = *(const LAS f32x4*)(gp + 8 * i + 4);
                const f32x4 va = *(const LAS f32x4*)(HT + t * HSTR + part * 32 + 8 * i), vb = *(const LAS f32x4*)(HT + t * HSTR + part * 32 + 8 * i + 4);
                const f32x4 oa = (va - mean) * rs * ga * sa, ob = (vb - mean) * rs * gb * sb;
                v4u w; w.x = pk2(oa.x, oa.y); w.y = pk2(oa.z, oa.w); w.z = pk2(ob.x, ob.y); w.w = pk2(ob.z, ob.w);
                *(v4u*)(HG + offh + 8 * i) = w; }
        }
    }
#undef ML_LOAD
    if (!FULL) {
#pragma unroll
        for (int i = 0; i < 8; ++i) {
#pragma unroll
            for (int n = 0; n < 2; ++n) *(f32x4*)(STC + ((size_t)(i * 2 + n) * 512 + tid) * 4) = Cacc[i][n];
            if (wave == 0) *(f32x4*)(STC + 32768 + ((size_t)i * 64 + lane) * 4) = Cacc[i][2];
        }
        if (tid == 0) { float s = 0.f;
#pragma unroll
            for (int c = 0; c < 8; ++c) s += LG[c];
            STG[unit] = s; }
    }
    __syncthreads();
}

__device__ __forceinline__ void mlstm_carry(const Params& p, int bid, int G) {
    const float* STG = (const float*)(p.ws + WS_STG);
    constexpr int NV4 = (int)(ST_UNIT / 16);
    for (int e = bid * 512 + (int)threadIdx.x; e < 16 * NV4; e += G * 512) {
        const int chain = e / NV4, i = e % NV4;
        f32x4 S = (f32x4){0.f, 0.f, 0.f, 0.f};
        f32x4 cl[15];
#pragma unroll
        for (int s = 0; s < 15; ++s) cl[s] = *((const f32x4*)(p.ws + WS_ST + (size_t)(chain * 16 + s) * ST_UNIT) + i);
        float eg[15];
#pragma unroll
        for (int s = 0; s < 15; ++s) eg[s] = STG[chain * 16 + s];
        asm volatile("" ::: "memory");
#pragma unroll
        for (int s = 0; s < 15; ++s) { S = __expf(eg[s]) * S + cl[s]; *((f32x4*)(p.ws + WS_ST2 + (size_t)(chain * 16 + s + 1) * ST_UNIT) + i) = S; }
    }
}


constexpr size_t WS_S5T = WS_END, WS_S5C = WS_S5T + 8 * MiB, WS_S5B = WS_S5C + 4 * MiB, WS_S5L = WS_S5B + 4 * MiB, WS_END2 = WS_S5L + 1 * MiB;
static_assert(WS_END2 <= WS_A8, "ws map");
constexpr size_t WS_XL = WS_Y32 + 100 * MiB;
constexpr size_t WS_XP = WS_Y32 + 132 * MiB;
constexpr int TSTR = 528, CSTR = 272;

__device__ __forceinline__ void s5_matrices(const Params& p, int l, int g, LAS unsigned char* lds, int tid) {
    LAS float* LPr = (LAS float*)lds; LAS float* LPi = LPr + 17 * 64; LAS float* Bbr = LPi + 17 * 64; LAS float* Bbi = Bbr + 1024;
    LAS float* Cr = Bbi + 1024; LAS float* Ci = Cr + 1024; LAS float* KM = Ci + 1024;
    const int lg = l * S5G + g;
    if (tid < 64) {
        const float lre = fminf(p.in[11][lg * 64 + tid], -1e-4f), lim = p.in[12][lg * 64 + tid], dt = expf(p.in[13][lg]);
        const float mag = expf(lre * dt), ang = lim * dt; const float br = mag * cosf(ang), bi = mag * sinf(ang);
        const float den = lre * lre + lim * lim, nr = br - 1.0f; const float rr = (nr * lre + bi * lim) / den, ri = (bi * lre - nr * lim) / den;
        float pr = 1.f, pi = 0.f;
        for (int t = 0; t <= 16; ++t) { LPr[t * 64 + tid] = pr; LPi[t * 64 + tid] = pi; const float a = pr * br - pi * bi, b2 = pr * bi + pi * br; pr = a; pi = b2; }
        const float* bre = p.in[14] + ((size_t)lg * 64 + tid) * 16; const float* bim = p.in[15] + ((size_t)lg * 64 + tid) * 16;
        for (int m = 0; m < 16; ++m) { const float b_r = bre[m], b_i = bim[m]; Bbr[tid * 16 + m] = rr * b_r - ri * b_i; Bbi[tid * 16 + m] = rr * b_i + ri * b_r; }
    }
    for (int e = tid; e < 1024; e += 512) { Cr[e] = p.in[16][(size_t)lg * 1024 + e]; Ci[e] = p.in[17][(size_t)lg * 1024 + e]; }
    __syncthreads();
    if (tid < 64) ((float2*)(p.ws + WS_S5L))[g * 64 + tid] = make_float2(LPr[16 * 64 + tid], LPi[16 * 64 + tid]);
    for (int e = tid; e < 4096; e += 512) { const int tau = e >> 8, n = (e >> 4) & 15, m = e & 15; float acc = 0.f;
        for (int q = 0; q < 64; ++q) { const float cr = Cr[n * 64 + q], ci = Ci[n * 64 + q], lr = LPr[tau * 64 + q], li = LPi[tau * 64 + q];
            const float clr = cr * lr - ci * li, cli = cr * li + ci * lr; acc += clr * Bbr[q * 16 + m] - cli * Bbi[q * 16 + m]; }
        KM[e] = acc; }
    __syncthreads();
    bf16* TO = (bf16*)(p.ws + WS_S5T) + (size_t)g * 65536; bf16* CPm = (bf16*)(p.ws + WS_S5C) + (size_t)g * 32768; bf16* BPm = (bf16*)(p.ws + WS_S5B) + (size_t)g * 32768;
    for (int ck = tid; ck < 8192; ck += 512) { const int row = ck >> 5, k0 = (ck & 31) * 8, s = k0 >> 4, m0 = k0 & 15, t = row >> 4, n = row & 15; float v[8];
#pragma unroll
        for (int e = 0; e < 8; ++e) v[e] = (s <= t) ? KM[(t - s) * 256 + n * 16 + m0 + e] : 0.f;
        v4u o; o.x = pk2(v[0], v[1]); o.y = pk2(v[2], v[3]); o.z = pk2(v[4], v[5]); o.w = pk2(v[6], v[7]); *(v4u*)(TO + (size_t)row * 256 + k0) = o; }
    for (int ck = tid; ck < 4096; ck += 512) { const int row = ck >> 4, k0 = (ck & 15) * 8, part = k0 >> 6, p0 = k0 & 63, t = row >> 4, n = row & 15; float v[8];
#pragma unroll
        for (int e = 0; e < 8; ++e) { const int q = p0 + e; const float cr = Cr[n * 64 + q], ci = Ci[n * 64 + q], lr = LPr[(t + 1) * 64 + q], li = LPi[(t + 1) * 64 + q]; v[e] = part ? -(cr * li + ci * lr) : (cr * lr - ci * li); }
        v4u o; o.x = pk2(v[0], v[1]); o.y = pk2(v[2], v[3]); o.z = pk2(v[4], v[5]); o.w = pk2(v[6], v[7]); *(v4u*)(CPm + (size_t)row * 128 + k0) = o; }
    for (int ck = tid; ck < 4096; ck += 512) { const int row = ck >> 5, k0 = (ck & 31) * 8, s = k0 >> 4, m0 = k0 & 15, part = row >> 6, q = row & 63, tau = 15 - s; float v[8];
        const float lr = LPr[tau * 64 + q], li = LPi[tau * 64 + q];
#pragma unroll
        for (int e = 0; e < 8; ++e) { const float b_r = Bbr[q * 16 + m0 + e], b_i = Bbi[q * 16 + m0 + e]; v[e] = part ? (lr * b_i + li * b_r) : (lr * b_r - li * b_i); }
        v4u o; o.x = pk2(v[0], v[1]); o.y = pk2(v[2], v[3]); o.z = pk2(v[4], v[5]); o.w = pk2(v[6], v[7]); *(v4u*)(BPm + (size_t)row * 256 + k0) = o; }
    __syncthreads();
}

__device__ __forceinline__ void s5_local(const Params& p, int unit, LAS unsigned char* lds, int tid_, int wave) {
    int tid = tid_; asm volatile("" : "+v"(tid));
    const int lane = tid & 63, g4 = lane >> 4, c16 = lane & 15;
    const int chain = unit >> 1, hf = unit & 1, b = chain >> 6, g = chain & 63;
    const bf16* U = (const bf16*)(p.ws + WS_U); float* XL = (float*)(p.ws + WS_XL);
    { const unsigned char* src = p.ws + WS_S5B + (size_t)g * 65536;
#pragma unroll
      for (int i = 0; i < 8; ++i) { const int ck = tid + 512 * i, row = ck >> 5, kc = ck & 31; *(LAS v4u*)(lds + row * TSTR + kc * 16) = *(const v4u*)(src + row * 512 + kc * 16); } }
    __syncthreads();
    f32x4 acc[8][2];
#pragma unroll
    for (int i = 0; i < 8; ++i) { acc[i][0] = (f32x4){0.f, 0.f, 0.f, 0.f}; acc[i][1] = (f32x4){0.f, 0.f, 0.f, 0.f}; }
    const int blk0 = 16 * (hf * 16 + 2 * wave) + c16;
#pragma unroll
    for (int ks = 0; ks < 8; ++ks) {
        bf16x8 bfr[2];
#pragma unroll
        for (int n2 = 0; n2 < 2; ++n2) bfr[n2] = *(const bf16x8*)(U + ((size_t)chain * SEQ + (blk0 + 16 * n2) * 16 + 2 * ks + (g4 >> 1)) * 16 + 8 * (g4 & 1));
#pragma unroll
        for (int mt = 0; mt < 8; ++mt) { const bf16x8 a = *(const LAS bf16x8*)(lds + (16 * mt + c16) * TSTR + (32 * ks + 8 * g4) * 2);
            acc[mt][0] = MFMA16(a, bfr[0], acc[mt][0]); acc[mt][1] = MFMA16(a, bfr[1], acc[mt][1]); }
    }
#pragma unroll
    for (int mt = 0; mt < 8; ++mt)
#pragma unroll
        for (int n2 = 0; n2 < 2; ++n2) *(f32x4*)(XL + ((size_t)chain * 512 + blk0 + 16 * n2) * 128 + 16 * mt + 4 * g4) = acc[mt][n2];
    __syncthreads();
}

__device__ __forceinline__ void s5_scan(const Params& p, int chain, LAS unsigned char* lds, int tid_, int wave) {
    int tid = tid_; asm volatile("" : "+v"(tid));
    const int lane = tid & 63, g = chain & 63;
    const float* XL = (const float*)(p.ws + WS_XL) + (size_t)chain * 512 * 128 + (size_t)(64 * wave) * 128 + lane; bf16* XP = (bf16*)(p.ws + WS_XP) + (size_t)chain * 512 * 128 + (size_t)(64 * wave) * 128 + lane;
    LAS float* Esr = (LAS float*)lds; LAS float* Esi = Esr + 512;
    float er[32], ei[32];
#define S5_LOAD_HALF(h) do { _Pragma("unroll") for (int j = 0; j < 32; ++j) { er[j] = XL[(32 * (h) + j) * 128]; ei[j] = XL[(32 * (h) + j) * 128 + 64]; } } while (0)
    S5_LOAD_HALF(1);
    asm volatile("" ::: "memory");
    const float2 lam = ((const float2*)(p.ws + WS_S5L))[g * 64 + lane];
    float x1r = er[0], x1i = ei[0];
#pragma unroll
    for (int j = 1; j < 32; ++j) { const float nr = lam.x * x1r - lam.y * x1i + er[j], ni = lam.x * x1i + lam.y * x1r + ei[j]; x1r = nr; x1i = ni; }
    asm volatile("" ::: "memory");
    S5_LOAD_HALF(0);
    float xr = er[0], xi = ei[0];
#pragma unroll
    for (int j = 1; j < 32; ++j) { const float nr = lam.x * xr - lam.y * xi + er[j], ni = lam.x * xi + lam.y * xr + ei[j]; xr = nr; xi = ni; }
    float pr = lam.x, pi = lam.y;
#pragma unroll
    for (int k = 0; k < 5; ++k) { const float nr = pr * pr - pi * pi, ni = 2.f * pr * pi; pr = nr; pi = ni; }
    Esr[wave * 64 + lane] = pr * xr - pi * xi + x1r; Esi[wave * 64 + lane] = pr * xi + pi * xr + x1i;
    __syncthreads();
    { const float nr = pr * pr - pi * pi, ni = 2.f * pr * pi; pr = nr; pi = ni; }
    xr = 0.f; xi = 0.f;
    for (int j = 0; j < wave; ++j) { const float ex = Esr[j * 64 + lane], ey = Esi[j * 64 + lane]; const float nr = pr * xr - pi * xi + ex, ni = pr * xi + pi * xr + ey; xr = nr; xi = ni; }
#pragma unroll
    for (int h = 0; h < 2; ++h) {
        if (h == 1) { asm volatile("" ::: "memory"); S5_LOAD_HALF(1); }
#pragma unroll
        for (int j = 0; j < 32; ++j) { XP[(32 * h + j) * 128] = (bf16)(pk2(xr, 0.f) & 0xffffu); XP[(32 * h + j) * 128 + 64] = (bf16)(pk2(xi, 0.f) & 0xffffu);
            const float nr = lam.x * xr - lam.y * xi + er[j], ni = lam.x * xi + lam.y * xr + ei[j]; xr = nr; xi = ni; }
    }
#undef S5_LOAD_HALF
    __syncthreads();
}

__device__ __forceinline__ void s5_final(const Params& p, int l, int unit, LAS unsigned char* lds, int tid_, int wave) {
    int tid = tid_; asm volatile("" : "+v"(tid));
    const int lane = tid & 63, g4 = lane >> 4, c16 = lane & 15;
    const int chain = unit >> 1, h2 = unit & 1, b = chain >> 6, g = chain & 63;
    const bf16* U = (const bf16*)(p.ws + WS_U); bf16* Z = (bf16*)(p.ws + WS_Z); const bf16* XP = (const bf16*)(p.ws + WS_XP) + (size_t)chain * 512 * 128;
    LAS unsigned char* ldT = lds; LAS unsigned char* ldC = lds + 128 * TSTR;
    { const unsigned char* srcT = p.ws + WS_S5T + (size_t)g * 131072 + (size_t)h2 * 128 * 512; const unsigned char* srcC = p.ws + WS_S5C + (size_t)g * 65536 + (size_t)h2 * 128 * 256;
#pragma unroll
      for (int i = 0; i < 8; ++i) { const int ck = tid + 512 * i, row = ck >> 5, kc = ck & 31; *(LAS v4u*)(ldT + row * TSTR + kc * 16) = *(const v4u*)(srcT + row * 512 + kc * 16); }
#pragma unroll
      for (int i = 0; i < 4; ++i) { const int ck = tid + 512 * i, row = ck >> 4, kc = ck & 15; *(LAS v4u*)(ldC + row * CSTR + kc * 16) = *(const v4u*)(srcC + row * 256 + kc * 16); } }
    float dsk[4];
#pragma unroll
    for (int r = 0; r < 4; ++r) dsk[r] = p.in[18][l * S5W + g * 16 + 4 * g4 + r];
    __syncthreads();
    const int nks = h2 ? 8 : 4;
#pragma unroll 1
    for (int np = 0; np < 2; ++np) {
        f32x4 acc[8][2];
#pragma unroll
        for (int i = 0; i < 8; ++i) { acc[i][0] = (f32x4){0.f, 0.f, 0.f, 0.f}; acc[i][1] = (f32x4){0.f, 0.f, 0.f, 0.f}; }
        const int blk0 = 16 * (4 * wave + 2 * np) + c16;
        bf16x8 bu[8][2], bx[4][2];
#pragma unroll
        for (int ks = 0; ks < 8; ++ks)
#pragma unroll
            for (int n2 = 0; n2 < 2; ++n2) if (ks < nks) bu[ks][n2] = *(const bf16x8*)(U + ((size_t)chain * SEQ + (blk0 + 16 * n2) * 16 + 2 * ks + (g4 >> 1)) * 16 + 8 * (g4 & 1));
#pragma unroll
        for (int ks = 0; ks < 4; ++ks)
#pragma unroll
            for (int n2 = 0; n2 < 2; ++n2) bx[ks][n2] = *(const bf16x8*)(XP + (size_t)(blk0 + 16 * n2) * 128 + 32 * ks + 8 * g4);
#pragma unroll
        for (int ks = 0; ks < 8; ++ks) if (ks < nks) {
#pragma unroll
            for (int mt = 0; mt < 8; ++mt) { const bf16x8 a = *(const LAS bf16x8*)(ldT + (16 * mt + c16) * TSTR + (32 * ks + 8 * g4) * 2);
                acc[mt][0] = MFMA16(a, bu[ks][0], acc[mt][0]); acc[mt][1] = MFMA16(a, bu[ks][1], acc[mt][1]); }
        }
#pragma unroll
        for (int ks = 0; ks < 4; ++ks) {
#pragma unroll
            for (int mt = 0; mt < 8; ++mt) { const bf16x8 a = *(const LAS bf16x8*)(ldC + (16 * mt + c16) * CSTR + (32 * ks + 8 * g4) * 2);
                acc[mt][0] = MFMA16(a, bx[ks][0], acc[mt][0]); acc[mt][1] = MFMA16(a, bx[ks][1], acc[mt][1]); }
        }
        v2u uus[8][2];
#pragma unroll
        for (int mt = 0; mt < 8; ++mt)
#pragma unroll
            for (int n2 = 0; n2 < 2; ++n2) uus[mt][n2] = *(const v2u*)(U + ((size_t)chain * SEQ + (blk0 + 16 * n2) * 16 + 8 * h2 + mt) * 16 + 4 * g4);
        asm volatile("" ::: "memory");
#pragma unroll
        for (int mt = 0; mt < 8; ++mt)
#pragma unroll
            for (int n2 = 0; n2 < 2; ++n2) { const size_t row = (size_t)b * SEQ + (blk0 + 16 * n2) * 16 + 8 * h2 + mt; const size_t off = row * S5W + g * 16 + 4 * g4;
                const v2u uu = uus[mt][n2];
                const float u4[4] = {__uint_as_float(uu.x << 16), __uint_as_float(uu.x & 0xffff0000u), __uint_as_float(uu.y << 16), __uint_as_float(uu.y & 0xffff0000u)};
                float z[4];
#pragma unroll
                for (int r = 0; r < 4; ++r) z[r] = gelu_tanh(acc[mt][n2][r] + dsk[r] * u4[r]);
                v2u w; w.x = pk2(z[0], z[1]); w.y = pk2(z[2], z[3]); *(v2u*)(Z + off) = w; }
    }
    __syncthreads();
}

__device__ __forceinline__ void layer_body(const Params& p, const int l, LAS unsigned char* lds, const XcdBarrier& bar, int wave, int G, int bid, int gw, int NGW) {
    unsigned char* ws = p.ws;
    bf16* XN = (bf16*)(ws + WS_XN); float* RS = (float*)(ws + WS_RS);
    bf16* Y16 = (bf16*)(ws + WS_Y32);

#define IN(k) (((MK_PH_MASK >> (k)) & 1) && p.ph_lo <= (k) && (k) < p.ph_hi)
#define NREP(k) ((((MK_DUP_MASK) >> (k)) & 1) ? 2 : 1)
#define FRESH() int tid = (int)threadIdx.x; asm volatile("" : "+v"(tid)); const int lane = tid & 63; (void)lane
#define SEAM(k) do { if (!(l == p.l_hi - 1 && (k) == p.ph_hi - 1)) xcd_barrier(bar); } while (0)
        if (IN(0)) { FRESH(); for (int g = bid; g < S5G; g += G) s5_matrices(p, l, g, lds, tid); _Pragma("unroll") for (int rep = 0; rep < NREP(0); ++rep) { prep_phase(p, l, lds, bid, G, wave, lane); __syncthreads(); } SEAM(0); }
        if (IN(1)) {
            { pg8::Gemm g{XN, (const bf16*)(ws + WS_WIN), M, 7168, D}; pg8::StaticOrder S; S.init(M, 7168, G, bid);
              pg8::EpiB<0> E{nullptr, 0, nullptr, nullptr, nullptr, (bf16*)(ws + WS_QK), (bf16*)(ws + WS_V), (bf16*)(ws + WS_SO), (bf16*)(ws + WS_U), (bf16*)(ws + WS_SGA), (bf16*)(ws + WS_SGB)};
              _Pragma("unroll") for (int rep = 0; rep < NREP(1); ++rep) pg8::gemm_phase<pg8::EpiB<0>, pg8::StaticOrder, true, true>(lds, g, S, E); }
            { FRESH(); gates_phase(XN, (const bf16*)(ws + WS_WIN) + (size_t)NP * D, (float*)(ws + WS_GATES), lds, gw, NGW, wave, lane); }
            SEAM(1);
        }
        if (IN(2)) {
            FRESH();
            _Pragma("unroll") for (int rep = 0; rep < 1 + MK_DUP_ML1; ++rep) {
            for (int unit = bid; unit < 256; unit += G) mlstm_unit<false>(p, l, unit, lds, tid, lane, wave);
            __syncthreads(); }
            _Pragma("unroll") for (int rep = 0; rep < 1 + MK_DUP_S51; ++rep) {
            for (int unit = bid; unit < 256; unit += G) s5_local(p, unit, lds, tid, wave);
            __syncthreads(); }
            SEAM(2);
        }
        if (IN(3)) { FRESH();
            if (G >= 256) { if (bid >= 128) mlstm_carry(p, bid - 128, G - 128); else s5_scan(p, bid, lds, tid, wave); }
            else { mlstm_carry(p, bid, G); for (int chain = bid; chain < 128; chain += G) s5_scan(p, chain, lds, tid, wave); }
            SEAM(3); }
        if (IN(4)) {
            FRESH();
            _Pragma("unroll") for (int rep = 0; rep < 1 + MK_DUP_ML2; ++rep) {
            for (int unit = bid; unit < 256; unit += G) mlstm_unit<true>(p, l, unit, lds, tid, lane, wave);
            __syncthreads(); }
            _Pragma("unroll") for (int rep = 0; rep < 1 + MK_DUP_S52; ++rep) {
            for (int unit = bid; unit < 256; unit += G) s5_final(p, l, unit, lds, tid, wave);
            __syncthreads(); }
            SEAM(4);
        }
        if (IN(5)) {
            pg8::Gemm g{(const bf16*)(ws + WS_Z), (const bf16*)(ws + WS_WGLU), M, S5W, S5W}; pg8::StaticOrder S; S.init(M, S5W, G, bid);
            pg8::EpiB<2> E{(bf16*)(ws + WS_HG) + MW, HZW, (const bf16*)(ws + WS_Z), nullptr, p.in[20] + (size_t)l * S5W, nullptr, nullptr, nullptr, nullptr, nullptr, nullptr, S5W};
            _Pragma("unroll") for (int rep = 0; rep < NREP(5); ++rep) pg8::gemm_phase<pg8::EpiB<2>, pg8::StaticOrder, true, true>(lds, g, S, E);
            { pg8::Gemm g{(const bf16*)(ws + WS_A8), (const bf16*)(ws + WS_W8), M, 8192, D / 2}; pg8::StaticOrder S; S.init(M, 8192, G, bid);
              pg8::EpiGate8 E{ws + WS_SG8A, ws + WS_SG8B, 1.0f / (A8_SCALE * W8_SCALE)};
              pg8::gemm_phase<pg8::EpiGate8, pg8::StaticOrder, true, true, 0, 0, false, true>(lds, g, S, E); }
            SEAM(5);
        }
        if (IN(6)) {
            pg8::Gemm g{(const bf16*)(ws + WS_HG), (const bf16*)(ws + WS_WPA), M, D, HZW, MW / 64}; pg8::StaticOrder S; S.init(M, D, G, bid);
            pg8::EpiMerge E{(bf16*)(ws + WS_SGA), ws + WS_SG8A, ws + WS_SG8B, D};
            pg8::gemm_phase<pg8::EpiMerge, pg8::StaticOrder, true, true, 0, 0, true>(lds, g, S, E);
            SEAM(6);
        }
        if (IN(7)) {
            pg8::Gemm g{(const bf16*)(ws + WS_SGA), (const bf16*)(ws + WS_WOUT), M, D, D}; pg8::StaticOrder S; S.init(M, D, G, bid);
            pg8::EpiB<5> E{Y16, D, nullptr, nullptr, nullptr, nullptr, nullptr, nullptr, nullptr, nullptr, nullptr};
            _Pragma("unroll") for (int rep = 0; rep < NREP(7); ++rep) pg8::gemm_phase<pg8::EpiB<5>, pg8::StaticOrder, true, true>(lds, g, S, E);
            SEAM(7);
        }
        if (IN(8)) { FRESH(); resid_rows(nullptr, XN, Y16, p.in[2] + (size_t)l * D, true, nullptr, RS, gw, NGW, lane); SEAM(8); }
        if (IN(9)) {
            pg8::Gemm g{XN, (const bf16*)(ws + WS_WFF1), M, DFF, D}; pg8::StaticOrder S; S.init(M, DFF, G, bid);
            pg8::EpiB<1> E{(bf16*)(ws + WS_H1), DFF, nullptr, nullptr, nullptr, nullptr, nullptr, nullptr, nullptr, nullptr, nullptr};
            _Pragma("unroll") for (int rep = 0; rep < NREP(9); ++rep) pg8::gemm_phase<pg8::EpiB<1>, pg8::StaticOrder, true, true>(lds, g, S, E);
            SEAM(9);
        }
        if (IN(10)) {
            pg8::Gemm g{(const bf16*)(ws + WS_H1), (const bf16*)(ws + WS_WFF2), M, D, DFF}; pg8::StaticOrder S; S.init(M, D, G, bid);
            pg8::EpiB<5> E{Y16, D, nullptr, nullptr, nullptr, nullptr, nullptr, nullptr, nullptr, nullptr, nullptr};
            _Pragma("unroll") for (int rep = 0; rep < NREP(10); ++rep) pg8::gemm_phase<pg8::EpiB<5>, pg8::StaticOrder, true, true, MK_FF2_AUXA, 0>(lds, g, S, E);
            SEAM(10);
        }
        if (IN(11)) { FRESH(); resid_rows(nullptr, XN, Y16, p.in[4] + (size_t)l * D, l + 1 < DEPTH, (l + 1 < DEPTH) ? nullptr : p.out, RS, gw, NGW, lane, nullptr, nullptr, ws + WS_A8); __syncthreads(); }
#undef IN
#undef SEAM
}

__global__ void __launch_bounds__(NWAVES * 64, 2) mk_fwd(Params p) {
    extern __shared__ __attribute__((aligned(16))) unsigned char lds_raw[];
    LAS unsigned char* lds = (LAS unsigned char*)lds_raw;
    const int tid = threadIdx.x, lane = tid & 63, wave = __builtin_amdgcn_readfirstlane(tid >> 6);
    const int G = gridDim.x, bid = blockIdx.x;
    const int gw = bid * NWAVES + wave, NGW = G * NWAVES;
    for (int u = tid; u < (LDS_BYTES - LDSCTL_OFF) / 4; u += NWAVES * 64) ((LAS unsigned*)(lds + LDSCTL_OFF))[u] = 0u;
    __syncthreads();
    unsigned* ctl = (unsigned*)(p.ws + WS_CTL);
    XcdBarrier bar = xcd_barrier_post(ctl + CW_BAR + p.li * XCD_BAR_WORDS, (volatile LAS unsigned*)(lds + MISC_OFF) + 8);
    if (p.l_lo <= 0 && 0 < p.l_hi) layer_body(p, 0, lds, bar, wave, G, bid, gw, NGW);
    if (p.l_lo <= 1 && 1 < p.l_hi) layer_body(p, 1, lds, bar, wave, G, bid, gw, NGW);
}

extern "C" void kernel_launch(void* const* d_in, const int* in_sizes, int n_in, void* d_out, int out_size, void* d_ws, size_t ws_size, hipStream_t stream) {
    static int grid = 0;
    if (grid == 0) {
        if (n_in != 25 || in_sizes[0] != M * D || out_size != M * D || ws_size < WS_END3) { fprintf(stderr, "kernel_launch: unexpected shapes (n_in %d, in0 %d, out %d, ws %zu); nothing launched\n", n_in, n_in > 0 ? in_sizes[0] : -1, out_size, ws_size); grid = -1; return; }
        int dev = 0, cus = 0, per_cu = 0;
        if (hipGetDevice(&dev) != hipSuccess || hipDeviceGetAttribute(&cus, hipDeviceAttributeMultiprocessorCount, dev) != hipSuccess) { grid = -1; return; }
        if (hipFuncSetAttribute((const void*)mk_fwd, hipFuncAttributeMaxDynamicSharedMemorySize, LDS_BYTES) != hipSuccess) { fprintf(stderr, "kernel_launch: hipFuncSetAttribute failed\n"); grid = -1; return; }
        if (hipOccupancyMaxActiveBlocksPerMultiprocessor(&per_cu, (const void*)mk_fwd, NWAVES * 64, LDS_BYTES) != hipSuccess || per_cu < 1) { fprintf(stderr, "kernel_launch: occupancy query says %d blocks per CU\n", per_cu); }
        (void)hipGetLastError();
        grid = cus;
    }
    if (grid < 0) return;
    if (hipMemsetAsync((char*)d_ws + WS_CTL, 0, CTL_ZERO_BYTES, stream) != hipSuccess) { fprintf(stderr, "kernel_launch: memset failed\n"); return; }
    Params a{};
    for (int i = 0; i < 25; ++i) a.in[i] = (const float*)d_in[i];
    a.out = (float*)d_out; a.ws = (unsigned char*)d_ws; a.pad = 0;
#if MK_ONE_LAUNCH
    a.l_lo = 0; a.l_hi = DEPTH; a.ph_lo = 0; a.ph_hi = NPH; a.li = 0;
    hipLaunchKernelGGL(mk_fwd, dim3(grid), dim3(NWAVES * 64), LDS_BYTES, stream, a);
#else
    for (int l = 0; l < DEPTH; ++l)
        for (int ph = 0; ph < NPH; ++ph) { a.l_lo = l; a.l_hi = l + 1; a.ph_lo = ph; a.ph_hi = ph + 1; a.li = 0;
            hipLaunchKernelGGL(mk_fwd, dim3(grid), dim3(NWAVES * 64), LDS_BYTES, stream, a); }
#endif
    const hipError_t le = hipPeekAtLastError();
    if (le != hipSuccess) fprintf(stderr, "kernel_launch: launch failed: %s\n", hipGetErrorName(le));
}
```
